# Optimizing an MI355X kernel written in HIP

```python
import jax, jax.numpy as jnp
from jax import lax
import numpy as np

D_MODEL = 2048
BATCH = 4
SEQ = 4096
DEPTH = 1

CHUNK = 64
HEAD_DIM = 128
N_HEADS_SB = 8
N_HEADS_CA = 8
SB_WIDTH = N_HEADS_SB * HEAD_DIM
CA_WIDTH = N_HEADS_CA * HEAD_DIM
N_BRANCH = 2
Q_BLOCK = 128
N_PAST_CHUNKS = 8
BAND = (N_PAST_CHUNKS + 1) * CHUNK
REL_CLIP_PAST = 128
N_REL = REL_CLIP_PAST + CHUNK
D_FF = 5632
IN_COLS = 3 * SB_WIDTH + 3 * CA_WIDTH + N_BRANCH * D_MODEL
EPS = 1e-6

kernel_name = "hybrid_stickbreak_chunkrel_macaron_block"


def _rmsnorm(x, gain):
    xf = x.astype(jnp.float32)
    y = xf * lax.rsqrt(jnp.mean(xf * xf, axis=-1, keepdims=True) + EPS)
    return (y * gain.astype(jnp.float32)).astype(x.dtype)


def _swiglu(x, w_gate, w_up, w_down):
    return (jax.nn.silu(x @ w_gate) * (x @ w_up)) @ w_down


def _split_heads(t, n_heads):
    b, s, _ = t.shape
    return t.reshape(b, s, n_heads, HEAD_DIM).transpose(0, 2, 1, 3)


def _merge_heads(t):
    b, h, s, dh = t.shape
    return t.transpose(0, 2, 1, 3).reshape(b, s, h * dh)


def _stick_breaking_attention(q, k, v):
    seq = q.shape[2]
    scale = HEAD_DIM ** -0.5
    outs = []
    for blk in range(seq // Q_BLOCK):
        q0 = blk * Q_BLOCK
        kend = q0 + Q_BLOCK
        qb = q[:, :, q0:kend]
        kb = k[:, :, :kend]
        vb = v[:, :, :kend]
        z = jnp.einsum('bhqd,bhkd->bhqk', qb, kb).astype(jnp.float32) * scale
        t_pos = q0 + np.arange(Q_BLOCK)[:, None]
        s_pos = np.arange(kend)[None, :]
        causal = s_pos < t_pos
        log_keep = jnp.where(causal, jax.nn.log_sigmoid(-z), 0.0)
        later = lax.cumsum(log_keep, axis=3, reverse=True) - log_keep
        log_w = jax.nn.log_sigmoid(z) + later
        w = jnp.where(causal, jnp.exp(log_w), 0.0)
        outs.append(jnp.einsum('bhqk,bhkd->bhqd', w.astype(v.dtype), vb))
    return jnp.concatenate(outs, axis=2)


def _chunked_relpos_attention(q, k, v, rel_bias):
    b, h, seq, dh = q.shape
    nc = seq // CHUNK
    scale = HEAD_DIM ** -0.5
    qc = q.reshape(b, h, nc, CHUNK, dh)
    pad = ((0, 0), (0, 0), (N_PAST_CHUNKS * CHUNK, 0), (0, 0))
    kp = jnp.pad(k, pad).reshape(b, h, nc + N_PAST_CHUNKS, CHUNK, dh)
    vp = jnp.pad(v, pad).reshape(b, h, nc + N_PAST_CHUNKS, CHUNK, dh)
    band_idx = np.arange(nc)[:, None] + np.arange(N_PAST_CHUNKS + 1)[None, :]
    kband = kp[:, :, band_idx].reshape(b, h, nc, BAND, dh)
    vband = vp[:, :, band_idx].reshape(b, h, nc, BAND, dh)
    scores = jnp.einsum('bhcqd,bhckd->bhcqk', qc, kband).astype(jnp.float32) * scale
    dist = np.arange(CHUNK)[:, None] + N_PAST_CHUNKS * CHUNK - np.arange(BAND)[None, :]
    rel_idx = np.clip(dist, -(CHUNK - 1), REL_CLIP_PAST) + (CHUNK - 1)
    bias = rel_bias.astype(jnp.float32)[:, rel_idx]
    scores = scores + bias[None, :, None]
    src_chunk = np.arange(nc)[:, None] - N_PAST_CHUNKS + np.arange(BAND)[None, :] // CHUNK
    valid = src_chunk >= 0
    scores = jnp.where(valid[None, None, :, None, :], scores, -jnp.inf)
    p = jax.nn.softmax(scores, axis=-1)
    out = jnp.einsum('bhcqk,bhckd->bhcqd', p.astype(v.dtype), vband)
    return out.reshape(b, h, seq, dh)


def setup_inputs(seed: int = 0) -> dict:
    key = jax.random.key(seed)
    ks = jax.random.split(key, 20)
    nrm = jax.random.normal
    f32 = jnp.float32

    def gain(k, shape):
        return 1.0 + 0.02 * nrm(k, shape, f32)

    return {
        "x": nrm(ks[0], (BATCH, SEQ, D_MODEL), f32),
        "ffn1_norm": gain(ks[1], (DEPTH, D_MODEL)),
        "ffn1_w_gate": nrm(ks[2], (DEPTH, D_MODEL, D_FF), f32) * D_MODEL ** -0.5,
        "ffn1_w_up": nrm(ks[3], (DEPTH, D_MODEL, D_FF), f32) * D_MODEL ** -0.5,
        "ffn1_w_down": nrm(ks[4], (DEPTH, D_FF, D_MODEL), f32) * D_FF ** -0.5,
        "mix_norm": gain(ks[5], (DEPTH, D_MODEL)),
        "w_in": nrm(ks[6], (DEPTH, D_MODEL, IN_COLS), f32) * D_MODEL ** -0.5,
        "b_gate": 0.05 * nrm(ks[7], (DEPTH, N_BRANCH * D_MODEL), f32),
        "q_norm_ca": gain(ks[8], (DEPTH, HEAD_DIM)),
        "k_norm_ca": gain(ks[9], (DEPTH, HEAD_DIM)),
        "rel_bias": 0.2 * nrm(ks[10], (DEPTH, N_HEADS_CA, N_REL), f32),
        "w_o_sb": nrm(ks[11], (DEPTH, SB_WIDTH, D_MODEL), f32) * SB_WIDTH ** -0.5,
        "w_o_ca": nrm(ks[12], (DEPTH, CA_WIDTH, D_MODEL), f32) * CA_WIDTH ** -0.5,
        "w_out": nrm(ks[13], (DEPTH, D_MODEL, D_MODEL), f32) * D_MODEL ** -0.5,
        "ffn2_norm": gain(ks[14], (DEPTH, D_MODEL)),
        "ffn2_w_gate": nrm(ks[15], (DEPTH, D_MODEL, D_FF), f32) * D_MODEL ** -0.5,
        "ffn2_w_up": nrm(ks[16], (DEPTH, D_MODEL, D_FF), f32) * D_MODEL ** -0.5,
        "ffn2_w_down": nrm(ks[17], (DEPTH, D_FF, D_MODEL), f32) * D_FF ** -0.5,
        "final_norm": gain(ks[18], (DEPTH, D_MODEL)),
    }


def reference(x, ffn1_norm, ffn1_w_gate, ffn1_w_up, ffn1_w_down, mix_norm, w_in, b_gate,
              q_norm_ca, k_norm_ca, rel_bias, w_o_sb, w_o_ca, w_out, ffn2_norm,
              ffn2_w_gate, ffn2_w_up, ffn2_w_down, final_norm):
    b, s, _ = x.shape
    split_at = [SB_WIDTH, 2 * SB_WIDTH, 3 * SB_WIDTH,
                3 * SB_WIDTH + CA_WIDTH, 3 * SB_WIDTH + 2 * CA_WIDTH, 3 * SB_WIDTH + 3 * CA_WIDTH]
    for l in range(DEPTH):
        x = x + 0.5 * _swiglu(_rmsnorm(x, ffn1_norm[l]), ffn1_w_gate[l], ffn1_w_up[l], ffn1_w_down[l])

        hn = _rmsnorm(x, mix_norm[l])
        proj = hn @ w_in[l]
        q_sb, k_sb, v_sb, q_ca, k_ca, v_ca, gate_pre = jnp.split(proj, split_at, axis=-1)

        y_sb = _stick_breaking_attention(_split_heads(q_sb, N_HEADS_SB),
                                         _split_heads(k_sb, N_HEADS_SB),
                                         _split_heads(v_sb, N_HEADS_SB))
        y_sb = _merge_heads(y_sb) @ w_o_sb[l]

        qh = _rmsnorm(_split_heads(q_ca, N_HEADS_CA), q_norm_ca[l])
        kh = _rmsnorm(_split_heads(k_ca, N_HEADS_CA), k_norm_ca[l])
        y_ca = _chunked_relpos_attention(qh, kh, _split_heads(v_ca, N_HEADS_CA), rel_bias[l])
        y_ca = _merge_heads(y_ca) @ w_o_ca[l]

        gates = jax.nn.sigmoid((gate_pre + b_gate[l]).astype(jnp.float32))
        gates = gates.reshape(b, s, N_BRANCH, D_MODEL).astype(x.dtype)
        merged = gates[:, :, 0] * y_sb + gates[:, :, 1] * y_ca
        x = x + merged @ w_out[l]

        x = x + 0.5 * _swiglu(_rmsnorm(x, ffn2_norm[l]), ffn2_w_gate[l], ffn2_w_up[l], ffn2_w_down[l])

        x = _rmsnorm(x, final_norm[l])
    return x
```

```cpp
#include <hip/hip_runtime.h>
#include <hip/hip_cooperative_groups.h>
#include <cstdio>
#include <cstdint>
namespace cg = cooperative_groups;
#ifndef MK_MULTI
#define MK_MULTI 0
#endif
namespace pg8 {
#define PG8_LAS __attribute__((address_space(3)))
typedef unsigned short bf16_t;
typedef short bf16x8 __attribute__((ext_vector_type(8)));
typedef float f32x4 __attribute__((ext_vector_type(4)));
typedef unsigned u32x4 __attribute__((ext_vector_type(4)));
constexpr int BM = 256, BK = 64, HALF = 128, HTB = HALF * BK * 2  , STAGE_BYTES = 8 * HTB, NXCD = 8, WGM = 4;

__host__ __device__ __forceinline__ int lds_byte(int r, int c) { const int st = (r >> 4) * 2 + (c >> 5), rr = r & 15, cc = c & 31, ob = rr * 64 + cc * 2; return st * 1024 + (ob ^ (((ob >> 9) & 1) << 5)); }
__host__ __device__ __forceinline__ void stage_rc(int b, int& R, int& C) { const int st = b / 1024, sb = b % 1024, swz = sb ^ (((sb >> 9) & 1) << 5); R = (st >> 1) * 16 + swz / 64; C = (st & 1) * 32 + (swz % 64) / 2; }
__host__ __device__ __forceinline__ int perm32(int rho) { const int n = rho >> 4, i = rho & 15; return 8 * (i >> 2) + 4 * n + (i & 3); }

struct Unit { int pm, pn; };
struct Gemm { const bf16_t* A; const bf16_t* Bt; int M, N, K; bool ablk = false, bblk = false; };

struct StaticOrder {
    int nM, nN, nwg, G, c;
    __host__ __device__ void init(int M, int N, int G_, int c_) { nM = M / BM; nN = N / BM; nwg = nM * nN; G = G_; c = c_; }
    __host__ __device__ bool next(int i, Unit& u) const {
        const long L = (long)i * G + c; if (L >= nwg) return false;
        int wgid = (int)L; { const int q = nwg / NXCD, r = nwg % NXCD, xcd = wgid % NXCD, off = wgid / NXCD; wgid = (xcd < r ? xcd * (q + 1) : r * (q + 1) + (xcd - r) * q) + off; }
        const int nig = WGM * nN, gid = wgid / nig, fm = gid * WGM, gsz = (nM - fm) < WGM ? (nM - fm) : WGM;
        u.pm = fm + ((wgid % nig) % gsz); u.pn = (wgid % nig) / gsz; return true;
    }
    __device__ __forceinline__ void a_ready(const Unit&) const {}
    __device__ __forceinline__ void done(const Unit&) const {}
};

__device__ __forceinline__ unsigned cvt_pk_bf16(float lo, float hi) { unsigned r; asm volatile("v_cvt_pk_bf16_f32 %0, %1, %2" : "=v"(r) : "v"(lo), "v"(hi)); return r; }
typedef float f32x2 __attribute__((ext_vector_type(2)));
template <class Epi, class Sched, bool ALIGN_EPI = false, bool SP2 = false>
__device__ __forceinline__ void gemm_phase(PG8_LAS unsigned char* lds, const Gemm g, const Sched& S, const Epi& E) {
    const int tid = threadIdx.x, wid = __builtin_amdgcn_readfirstlane(tid >> 6), lane = tid & 63, wr = wid >> 2, wc = wid & 3, fr = lane & 15, fq = lane >> 4;
    const int K = g.K, nt = K / BK;
    unsigned voffA[2], voffB[2];
#pragma unroll
    for (int i = 0; i < 2; ++i) { int R, C; stage_rc(tid * 16 + i * 8192, R, C); const int Rb = Epi::PERM ? ((R & ~31) + perm32(R & 31)) : R;
        voffA[i] = (unsigned)(R * (g.ablk ? BK : K) + C) * 2u; voffB[i] = (unsigned)(Rb * (g.bblk ? BK : K) + C) * 2u; }
    const size_t kstA = g.ablk ? (size_t)(BM * BK * 2) : (size_t)(BK * 2), kstB = g.bblk ? (size_t)(BM * BK * 2) : (size_t)(BK * 2);
    const size_t hstA = g.ablk ? (size_t)(HALF * BK * 2) : (size_t)HALF * K * 2, hstB = g.bblk ? (size_t)(HALF * BK * 2) : (size_t)HALF * K * 2;
    const size_t tstA = (size_t)BM * K * 2, tstB = (size_t)BM * K * 2;
    const unsigned ldsw = (unsigned)wid * 1024u;
    const int aoff = lds_byte(wr * 64 + fr, fq * 8), boff = lds_byte(wc * 32 + fr, fq * 8);
#define PG8_SA(b, h) (((b) * 2 + (h)) * HTB)
#define PG8_SB(b, h) ((4 + (b) * 2 + (h)) * HTB)
#define PG8_STAGE(bufoff, gbase, voff) do { _Pragma("unroll") for (int _i = 0; _i < 2; ++_i) \
        __builtin_amdgcn_global_load_lds((const unsigned*)((const char*)(gbase) + (voff)[_i]), (PG8_LAS unsigned*)(lds + (bufoff) + ldsw + _i * 8192), 16, 0, 0); } while (0)
#define PG8_LDA(dst, b, h) do { _Pragma("unroll") for (int m = 0; m < 4; ++m) _Pragma("unroll") for (int k = 0; k < 2; ++k) dst[m][k] = *(const PG8_LAS bf16x8*)(lds + PG8_SA(b, h) + aoff + m * 2048 + k * 1024); } while (0)
#define PG8_LDB(dst, b, h) do { _Pragma("unroll") for (int n = 0; n < 2; ++n) _Pragma("unroll") for (int k = 0; k < 2; ++k) dst[n][k] = *(const PG8_LAS bf16x8*)(lds + PG8_SB(b, h) + boff + n * 2048 + k * 1024); } while (0)
#define PG8_MMA(ai, bj, At, Bt) do { __builtin_amdgcn_s_setprio(1); _Pragma("unroll") for (int m = 0; m < 4; ++m) _Pragma("unroll") for (int n = 0; n < 2; ++n) _Pragma("unroll") for (int k = 0; k < 2; ++k) \
        acc[ai][bj][m][n] = __builtin_amdgcn_mfma_f32_16x16x32_bf16(Bt[n][k], At[m][k], acc[ai][bj][m][n], 0, 0, 0); __builtin_amdgcn_s_setprio(0); } while (0)
#define PG8_WAIT_V(n) asm volatile("s_waitcnt vmcnt(" #n ")" ::: "memory")
#define PG8_WAIT_L(n) asm volatile("s_waitcnt lgkmcnt(" #n ")" ::: "memory")
#define PG8_BAR __builtin_amdgcn_s_barrier()
#define PG8_SCHED __builtin_amdgcn_sched_barrier(0)
    Unit cur, nxt; int ui = 0;
    if (!S.next(0, cur)) return;
    f32x4 acc[2][2][4][2];
#pragma unroll
    for (int a = 0; a < 2; ++a)
#pragma unroll
        for (int b = 0; b < 2; ++b)
#pragma unroll
            for (int m = 0; m < 4; ++m)
#pragma unroll
                for (int n = 0; n < 2; ++n) acc[a][b][m][n] = (f32x4){0.f, 0.f, 0.f, 0.f};
    bf16x8 At[4][2], B0[2][2], B1[2][2];
    const char* cA = (const char*)g.A + (size_t)cur.pm * tstA; const char* cB = (const char*)g.Bt + (size_t)cur.pn * tstB;
    S.a_ready(cur);
    if constexpr (SP2) {
        PG8_STAGE(PG8_SB(0, 0), cB, voffB); PG8_STAGE(PG8_SB(0, 1), cB + hstB, voffB); PG8_STAGE(PG8_SA(0, 0), cA, voffA); PG8_STAGE(PG8_SA(0, 1), cA + hstA, voffA);
        if (wr == 1) PG8_BAR;
        PG8_WAIT_V(2); PG8_BAR;
        PG8_STAGE(PG8_SB(1, 0), cB + kstB, voffB); PG8_STAGE(PG8_SA(1, 0), cA + kstA, voffA); PG8_STAGE(PG8_SB(1, 1), cB + hstB + kstB, voffB);
        PG8_WAIT_V(6); PG8_BAR;
    } else {
        PG8_STAGE(PG8_SB(0, 0), cB, voffB); PG8_STAGE(PG8_SA(0, 0), cA, voffA); PG8_STAGE(PG8_SB(0, 1), cB + hstB, voffB); PG8_STAGE(PG8_SA(0, 1), cA + hstA, voffA);
        if (wr == 1) PG8_BAR;
        PG8_WAIT_V(4); PG8_BAR;
        PG8_STAGE(PG8_SB(1, 0), cB + kstB, voffB); PG8_STAGE(PG8_SA(1, 0), cA + kstA, voffA); PG8_STAGE(PG8_SB(1, 1), cB + hstB + kstB, voffB);
        PG8_WAIT_V(6); PG8_BAR;
    }
    for (;;) {
        const bool has_next = S.next(ui + 1, nxt);
        const char* nA = has_next ? (const char*)g.A + (size_t)nxt.pm * tstA : cA; const char* nB = has_next ? (const char*)g.Bt + (size_t)nxt.pn * tstB : cB;
        for (int t = 0; t < nt; t += 2) {
            const bool last = (t == nt - 2);
            const char* a1 = cA + (size_t)(t + 1) * kstA;
            const char* a2 = last ? nA : cA + (size_t)(t + 2) * kstA; const char* b2 = last ? nB : cB + (size_t)(t + 2) * kstB;
            const char* a3 = a2 + kstA; const char* b3 = b2 + kstB;
            if (last && has_next) S.a_ready(nxt);
            if constexpr (SP2) {
            PG8_LDB(B0, 0, 0); PG8_LDB(B1, 0, 1); PG8_SCHED; PG8_LDA(At, 0, 0); PG8_STAGE(PG8_SA(1, 1), a1 + hstA, voffA);
            PG8_WAIT_V(8); PG8_WAIT_L(0); PG8_BAR; PG8_MMA(0, 0, At, B0); PG8_MMA(0, 1, At, B1); PG8_BAR; PG8_SCHED;
            PG8_LDA(At, 0, 1); PG8_STAGE(PG8_SB(0, 0), b2, voffB); PG8_STAGE(PG8_SB(0, 1), b2 + hstB, voffB); PG8_STAGE(PG8_SA(0, 0), a2, voffA);
            PG8_WAIT_V(8); PG8_WAIT_L(0); PG8_BAR; PG8_MMA(1, 0, At, B0); PG8_MMA(1, 1, At, B1); PG8_BAR; PG8_SCHED;
            PG8_LDB(B0, 1, 0); PG8_LDB(B1, 1, 1); PG8_SCHED; PG8_LDA(At, 1, 0); PG8_STAGE(PG8_SA(0, 1), a2 + hstA, voffA);
            PG8_WAIT_V(8); PG8_WAIT_L(0); PG8_BAR; PG8_MMA(0, 0, At, B0); PG8_MMA(0, 1, At, B1); PG8_BAR; PG8_SCHED;
            PG8_LDA(At, 1, 1); PG8_STAGE(PG8_SB(1, 0), b3, voffB); PG8_STAGE(PG8_SB(1, 1), b3 + hstB, voffB); PG8_STAGE(PG8_SA(1, 0), a3, voffA);
            PG8_WAIT_V(8); PG8_WAIT_L(0); PG8_BAR; PG8_MMA(1, 0, At, B0); PG8_MMA(1, 1, At, B1); PG8_BAR; PG8_SCHED;
            } else {
            PG8_LDB(B0, 0, 0); PG8_SCHED; PG8_LDA(At, 0, 0); PG8_STAGE(PG8_SA(1, 1), a1 + hstA, voffA);
            PG8_WAIT_L(8); PG8_BAR; PG8_WAIT_L(0); PG8_MMA(0, 0, At, B0); PG8_BAR; PG8_SCHED;
            PG8_LDB(B1, 0, 1); PG8_STAGE(PG8_SB(0, 0), b2, voffB);
            PG8_BAR; PG8_WAIT_L(0); PG8_MMA(0, 1, At, B1); PG8_BAR;
            PG8_LDA(At, 0, 1); PG8_STAGE(PG8_SA(0, 0), a2, voffA);
            PG8_BAR; PG8_WAIT_L(0); PG8_MMA(1, 0, At, B0); PG8_BAR; PG8_SCHED;
            PG8_STAGE(PG8_SB(0, 1), b2 + hstB, voffB);
            PG8_WAIT_V(6); PG8_BAR; PG8_MMA(1, 1, At, B1); PG8_BAR;
            PG8_LDB(B0, 1, 0); PG8_SCHED; PG8_LDA(At, 1, 0); PG8_STAGE(PG8_SA(0, 1), a2 + hstA, voffA);
            PG8_WAIT_L(8); PG8_BAR; PG8_WAIT_L(0); PG8_MMA(0, 0, At, B0); PG8_BAR; PG8_SCHED;
            PG8_LDB(B1, 1, 1); PG8_STAGE(PG8_SB(1, 0), b3, voffB);
            PG8_BAR; PG8_WAIT_L(0); PG8_MMA(0, 1, At, B1); PG8_BAR;
            PG8_LDA(At, 1, 1); PG8_STAGE(PG8_SA(1, 0), a3, voffA);
            PG8_BAR; PG8_WAIT_L(0); PG8_MMA(1, 0, At, B0); PG8_BAR; PG8_SCHED;
            PG8_STAGE(PG8_SB(1, 1), b3 + hstB, voffB);
            PG8_WAIT_V(6); PG8_BAR; PG8_MMA(1, 1, At, B1); PG8_BAR;
            }
            if constexpr (Epi::MID_T >= 0) { if (t == Epi::MID_T) E.mid(acc, cur, wr, wc, fr, fq); }
        }
        if constexpr (ALIGN_EPI) { if (wr == 0) PG8_BAR; }
        if constexpr (!Epi::AFTER_DRAIN) { E(acc, cur, wr, wc, fr, fq); S.done(cur); }
        if (!has_next) break;
#pragma unroll
        for (int a = 0; a < 2; ++a)
#pragma unroll
            for (int b = 0; b < 2; ++b)
#pragma unroll
                for (int m = 0; m < 4; ++m)
#pragma unroll
                    for (int n = 0; n < 2; ++n) acc[a][b][m][n] = (f32x4){0.f, 0.f, 0.f, 0.f};
        cur = nxt; cA = nA; cB = nB; ++ui;
        if constexpr (ALIGN_EPI) { if (wr == 1) PG8_BAR; }
    }
    PG8_WAIT_V(0);
    if constexpr (!ALIGN_EPI) { if (wr == 0) PG8_BAR; }
    PG8_BAR;
    if constexpr (Epi::AFTER_DRAIN) { E.fused(acc, cur, wr, wc, fr, fq, lds, wid, lane); S.done(cur); }
#undef PG8_SA
#undef PG8_SB
#undef PG8_STAGE
#undef PG8_LDA
#undef PG8_LDB
#undef PG8_MMA
#undef PG8_WAIT_V
#undef PG8_WAIT_L
#undef PG8_BAR
#undef PG8_SCHED
}
}

constexpr int M = 16384, SEQ = 4096, DM = 2048, DFF = 5632, NIN = 10240, HW = 1024, NSS = 32, QP = 2048;
constexpr float EPS = 1e-6f, LOG2E = 1.4426950408889634f;
constexpr float C2 = 0.08838834764831845f * 1.4426950408889634f;

typedef unsigned short bf16;
typedef unsigned u32x4 __attribute__((ext_vector_type(4)));
typedef unsigned u32x2 __attribute__((ext_vector_type(2)));
typedef float f32x4 __attribute__((ext_vector_type(4)));
typedef float f32x16 __attribute__((ext_vector_type(16)));
typedef short bf16x8 __attribute__((ext_vector_type(8)));
typedef short s16x4 __attribute__((ext_vector_type(4)));
#define LAS __attribute__((address_space(3)))
typedef LAS unsigned char* ldsp;

__device__ __forceinline__ float bflo(unsigned w) { return __uint_as_float(w << 16); }
__device__ __forceinline__ float bfhi(unsigned w) { return __uint_as_float(w & 0xffff0000u); }
__device__ __forceinline__ unsigned pk2(float lo, float hi) { return pg8::cvt_pk_bf16(lo, hi); }
__device__ __forceinline__ float fast_sigmoid(float v) { return __builtin_amdgcn_rcpf(1.0f + __builtin_amdgcn_exp2f(-v * LOG2E)); }

namespace pg8 {
__device__ __forceinline__ float row_rstd(const float* ss, int row, int fq) {
    const f32x4* p = (const f32x4*)(ss + (size_t)row * NSS + 8 * fq);
    const f32x4 a = p[0], b = p[1];
    float s = ((a[0] + a[1]) + (a[2] + a[3])) + ((b[0] + b[1]) + (b[2] + b[3]));
    s += __shfl_xor(s, 16); s += __shfl_xor(s, 32);
    return rsqrtf(s * (1.0f / DM) + EPS);
}
__device__ __forceinline__ void rstd8(const float* ss, int row0, int fq, float (&rsv)[8]) {
#pragma unroll
    for (int i = 0; i < 8; ++i) rsv[i] = row_rstd(ss, row0 + (i >> 2) * HALF + (i & 3) * 16, fq);
}
struct EpiSwiglu {
    static constexpr bool PERM = true, AFTER_DRAIN = false; static constexpr int MID_T = -1;
    bf16_t* H; const float* ss; mutable int cpm = -1; mutable float rsv[8] = {};
    __device__ __forceinline__ void operator()(const f32x4 (&acc)[2][2][4][2], const Unit& u, int wr, int wc, int fr, int fq) const {
        const int row0 = u.pm * BM + wr * 64 + fr, col0 = u.pn * 128 + wc * 32 + 8 * fq;
        if (u.pm != cpm) { cpm = u.pm; rstd8(ss, row0, fq, rsv); }
#pragma unroll
        for (int ai = 0; ai < 2; ++ai)
#pragma unroll
            for (int m = 0; m < 4; ++m) {
                const int row = row0 + ai * HALF + m * 16; const float rs = rsv[ai * 4 + m];
                float hv[8];
#pragma unroll
                for (int n = 0; n < 2; ++n)
#pragma unroll
                    for (int e = 0; e < 4; ++e) { const float g = acc[ai][0][m][n][e] * rs, uu = acc[ai][1][m][n][e] * rs; hv[n * 4 + e] = g * fast_sigmoid(g) * uu; }
                u32x4 w; w.x = cvt_pk_bf16(hv[0], hv[1]); w.y = cvt_pk_bf16(hv[2], hv[3]); w.z = cvt_pk_bf16(hv[4], hv[5]); w.w = cvt_pk_bf16(hv[6], hv[7]);
                *(u32x4*)(H + (((size_t)(row >> 8) * (DFF / 64) + (col0 >> 6)) * 256 + (row & 255)) * 64 + (col0 & 63)) = w;
            }
    }
};
template <bool RESBF> struct EpiResid {
    static constexpr bool PERM = true, AFTER_DRAIN = false; static constexpr int MID_T = -1;
    const void* res; float* out; bf16_t* xb; float* ss; float alpha;
    __device__ __forceinline__ void operator()(const f32x4 (&acc)[2][2][4][2], const Unit& u, int wr, int wc, int fr, int fq) const {
        const int row0 = u.pm * BM + wr * 64 + fr, col0 = u.pn * BM + wc * 32 + 8 * fq;
        u32x4 pre[2][4][2];
        if (RESBF) {
#pragma unroll
            for (int ai = 0; ai < 2; ++ai)
#pragma unroll
                for (int m = 0; m < 4; ++m)
#pragma unroll
                    for (int bj = 0; bj < 2; ++bj) pre[ai][m][bj] = *(const u32x4*)((const bf16_t*)res + (size_t)(row0 + ai * HALF + m * 16) * DM + col0 + bj * HALF);
        }
#pragma unroll
        for (int ai = 0; ai < 2; ++ai)
#pragma unroll
            for (int m = 0; m < 4; ++m) {
                const int row = row0 + ai * HALF + m * 16; const size_t off = (size_t)row * DM + col0; float s = 0.f;
#pragma unroll
                for (int bj = 0; bj < 2; ++bj) {
                    f32x4 r0, r1;
                    if (RESBF) { const u32x4 p = pre[ai][m][bj]; r0 = (f32x4){bflo(p.x), bfhi(p.x), bflo(p.y), bfhi(p.y)}; r1 = (f32x4){bflo(p.z), bfhi(p.z), bflo(p.w), bfhi(p.w)}; }
                    else { r0 = *(const f32x4*)((const float*)res + off + bj * HALF); r1 = *(const f32x4*)((const float*)res + off + bj * HALF + 4); }
                    const f32x4 v0 = r0 + acc[ai][bj][m][0] * alpha, v1 = r1 + acc[ai][bj][m][1] * alpha;
                    if (out) { *(f32x4*)(out + off + bj * HALF) = v0; *(f32x4*)(out + off + bj * HALF + 4) = v1; }
                    s += ((v0[0] * v0[0] + v0[1] * v0[1]) + (v0[2] * v0[2] + v0[3] * v0[3])) + ((v1[0] * v1[0] + v1[1] * v1[1]) + (v1[2] * v1[2] + v1[3] * v1[3]));
                    if (xb) { u32x4 w; w.x = cvt_pk_bf16(v0[0], v0[1]); w.y = cvt_pk_bf16(v0[2], v0[3]); w.z = cvt_pk_bf16(v1[0], v1[1]); w.w = cvt_pk_bf16(v1[2], v1[3]); *(u32x4*)(xb + off + bj * HALF) = w; }
                }
                s += __shfl_xor(s, 16); s += __shfl_xor(s, 32);
                if (fq == 0) ss[(size_t)row * NSS + u.pn * 4 + wc] = s;
            }
    }
};
struct EpiIn {
    static constexpr bool PERM = true, AFTER_DRAIN = false; static constexpr int MID_T = -1;
    bf16_t *qsb, *ksb, *vsb, *qca, *kca, *vca, *gates; float* qkss; const float* ss; const float* bgate;
    __device__ __forceinline__ void operator()(const f32x4 (&acc)[2][2][4][2], const Unit& u, int wr, int wc, int fr, int fq) const {
        const int row0 = u.pm * BM + wr * 64 + fr; const int pn = u.pn;
        if (pn < 24) {
            const int t = pn >> 2; bf16_t* dst = t == 0 ? qsb : t == 1 ? ksb : t == 2 ? vsb : t == 3 ? qca : t == 4 ? kca : vca;
            const float sc = (t == 0) ? C2 : 1.0f; const bool stat = (t == 3 || t == 4);
            const int col0 = (pn & 3) * BM + wc * 32 + 8 * fq;
#pragma unroll
            for (int ai = 0; ai < 2; ++ai)
#pragma unroll
                for (int m = 0; m < 4; ++m) {
                    const int row = row0 + ai * HALF + m * 16; const float rs = row_rstd(ss, row, fq) * sc;
#pragma unroll
                    for (int bj = 0; bj < 2; ++bj) {
                        const f32x4 v0 = acc[ai][bj][m][0] * rs, v1 = acc[ai][bj][m][1] * rs;
                        u32x4 w; w.x = cvt_pk_bf16(v0[0], v0[1]); w.y = cvt_pk_bf16(v0[2], v0[3]); w.z = cvt_pk_bf16(v1[0], v1[1]); w.w = cvt_pk_bf16(v1[2], v1[3]);
                        *(u32x4*)(dst + (size_t)row * ((t == 0 || t == 3) ? QP : HW) + col0 + bj * HALF) = w;
                        if (stat) {
                            float s = ((v0[0] * v0[0] + v0[1] * v0[1]) + (v0[2] * v0[2] + v0[3] * v0[3])) + ((v1[0] * v1[0] + v1[1] * v1[1]) + (v1[2] * v1[2] + v1[3] * v1[3]));
                            s += __shfl_xor(s, 16); s += __shfl_xor(s, 32);
                            if (fq == 0) qkss[(size_t)row * 64 + ((t - 3) * 8 + (pn & 3) * 2 + bj) * 4 + wc] = s;
                        }
                    }
                }
        } else {
            const int col0 = (pn - 24) * BM + wc * 32 + 8 * fq;
            f32x4 bv[2][2];
#pragma unroll
            for (int bj = 0; bj < 2; ++bj)
#pragma unroll
                for (int n = 0; n < 2; ++n) bv[bj][n] = *(const f32x4*)(bgate + col0 + bj * HALF + 4 * n);
#pragma unroll
            for (int ai = 0; ai < 2; ++ai)
#pragma unroll
                for (int m = 0; m < 4; ++m) {
                    const int row = row0 + ai * HALF + m * 16; const float rs = row_rstd(ss, row, fq);
#pragma unroll
                    for (int bj = 0; bj < 2; ++bj) {
                        const f32x4 v0 = acc[ai][bj][m][0] * rs + bv[bj][0], v1 = acc[ai][bj][m][1] * rs + bv[bj][1];
                        u32x4 w; w.x = cvt_pk_bf16(fast_sigmoid(v0[0]), fast_sigmoid(v0[1])); w.y = cvt_pk_bf16(fast_sigmoid(v0[2]), fast_sigmoid(v0[3]));
                        w.z = cvt_pk_bf16(fast_sigmoid(v1[0]), fast_sigmoid(v1[1])); w.w = cvt_pk_bf16(fast_sigmoid(v1[2]), fast_sigmoid(v1[3]));
                        *(u32x4*)(gates + (size_t)row * (2 * DM) + col0 + bj * HALF) = w;
                    }
                }
        }
    }
};
struct EpiGateF {
    static constexpr bool PERM = true, AFTER_DRAIN = false; static constexpr int MID_T = 14;
    const bf16_t* gates; bf16_t* G;
    __device__ __forceinline__ void mid(f32x4 (&acc)[2][2][4][2], const Unit& u, int wr, int wc, int fr, int fq) const {
        asm volatile("" : "+v"(fr), "+v"(fq));
        const int row0 = u.pm * BM + wr * 64 + fr, col0 = u.pn * BM + wc * 32 + 8 * fq;
#pragma unroll
        for (int ai = 0; ai < 2; ++ai)
#pragma unroll
            for (int m = 0; m < 4; ++m) {
                const int row = row0 + ai * HALF + m * 16;
#pragma unroll
                for (int bj = 0; bj < 2; ++bj) {
                    const bf16_t* gp = gates + (size_t)row * (2 * DM) + col0 + bj * HALF;
                    const u32x4 ga = *(const u32x4*)gp, gb = *(const u32x4*)(gp + DM);
                    const float ra[8] = {bflo(ga.x), bfhi(ga.x), bflo(ga.y), bfhi(ga.y), bflo(ga.z), bfhi(ga.z), bflo(ga.w), bfhi(ga.w)};
                    const float rb[8] = {bflo(gb.x), bfhi(gb.x), bflo(gb.y), bfhi(gb.y), bflo(gb.z), bfhi(gb.z), bflo(gb.w), bfhi(gb.w)};
#pragma unroll
                    for (int e = 0; e < 4; ++e) { acc[ai][bj][m][0][e] *= ra[e] * __builtin_amdgcn_rcpf(__builtin_fmaxf(rb[e], 1e-30f)); acc[ai][bj][m][1][e] *= ra[4 + e] * __builtin_amdgcn_rcpf(__builtin_fmaxf(rb[4 + e], 1e-30f)); }
                }
                if (m & 1) asm volatile("" ::: "memory");
            }
    }
    __device__ __forceinline__ void operator()(const f32x4 (&acc)[2][2][4][2], const Unit& u, int wr, int wc, int fr, int fq) const {
        const int row0 = u.pm * BM + wr * 64 + fr, col0 = u.pn * BM + wc * 32 + 8 * fq;
#pragma unroll
        for (int ai = 0; ai < 2; ++ai)
#pragma unroll
            for (int m = 0; m < 4; ++m) {
                const int row = row0 + ai * HALF + m * 16;
#pragma unroll
                for (int bj = 0; bj < 2; ++bj) {
                    const u32x4 gb = *(const u32x4*)(gates + (size_t)row * (2 * DM) + DM + col0 + bj * HALF);
                    const f32x4 a0 = acc[ai][bj][m][0], a1 = acc[ai][bj][m][1];
                    const float v[8] = {__builtin_fmaxf(bflo(gb.x), 1e-30f) * a0[0], __builtin_fmaxf(bfhi(gb.x), 1e-30f) * a0[1], __builtin_fmaxf(bflo(gb.y), 1e-30f) * a0[2], __builtin_fmaxf(bfhi(gb.y), 1e-30f) * a0[3],
                                        __builtin_fmaxf(bflo(gb.z), 1e-30f) * a1[0], __builtin_fmaxf(bfhi(gb.z), 1e-30f) * a1[1], __builtin_fmaxf(bflo(gb.w), 1e-30f) * a1[2], __builtin_fmaxf(bfhi(gb.w), 1e-30f) * a1[3]};
                    u32x4 w; w.x = cvt_pk_bf16(v[0], v[1]); w.y = cvt_pk_bf16(v[2], v[3]); w.z = cvt_pk_bf16(v[4], v[5]); w.w = cvt_pk_bf16(v[6], v[7]);
                    *(u32x4*)(G + (size_t)row * DM + col0 + bj * HALF) = w;
                }
            }
    }
};
struct PanelOrder {
    int c;
    __host__ __device__ void init(int c_) { c = c_; }
    __host__ __device__ bool next(int i, Unit& u) const { if (i >= 2) return false; const int xcd = c & 7, idx = c >> 3; u.pm = 32 * i + 4 * xcd + (idx >> 3); u.pn = idx & 7; return true; }
    __device__ __forceinline__ void a_ready(const Unit&) const {}
    __device__ __forceinline__ void done(const Unit&) const {}
};
struct EpiFinal {
    static constexpr bool PERM = true, AFTER_DRAIN = false; static constexpr int MID_T = -1;
    const bf16_t* res; float* out; const float* gain; float* xs; unsigned* cnt; PG8_LAS unsigned char* ldsx; float alpha;
    __device__ __forceinline__ void operator()(f32x4 (&acc)[2][2][4][2], const Unit& u, int wr, int wc, int fr, int fq) const {
        const int tid = threadIdx.x, lane = tid & 63, wid = __builtin_amdgcn_readfirstlane(tid >> 6);
        PG8_LAS float* P = (PG8_LAS float*)ldsx;
        PG8_LAS float* S = (PG8_LAS float*)(ldsx + 4096);
        const int rl0 = wr * 64 + fr, col0 = u.pn * BM + wc * 32 + 8 * fq;
#pragma unroll
        for (int ai = 0; ai < 2; ++ai)
#pragma unroll
            for (int m = 0; m < 4; ++m) {
                const int rl = rl0 + ai * HALF + m * 16; const size_t off = (size_t)(u.pm * BM + rl) * DM + col0; float s = 0.f;
#pragma unroll
                for (int bj = 0; bj < 2; ++bj) {
                    const u32x4 p = *(const u32x4*)(res + off + bj * HALF);
                    const f32x4 v0 = (f32x4){bflo(p.x), bfhi(p.x), bflo(p.y), bfhi(p.y)} + acc[ai][bj][m][0] * alpha, v1 = (f32x4){bflo(p.z), bfhi(p.z), bflo(p.w), bfhi(p.w)} + acc[ai][bj][m][1] * alpha;
                    acc[ai][bj][m][0] = v0; acc[ai][bj][m][1] = v1;
                    s += ((v0[0] * v0[0] + v0[1] * v0[1]) + (v0[2] * v0[2] + v0[3] * v0[3])) + ((v1[0] * v1[0] + v1[1] * v1[1]) + (v1[2] * v1[2] + v1[3] * v1[3]));
                }
                s += __shfl_xor(s, 16); s += __shfl_xor(s, 32);
                if (fq == 0) P[rl * 4 + wc] = s;
            }
        asm volatile("s_waitcnt lgkmcnt(0)" ::: "memory"); __builtin_amdgcn_s_barrier(); asm volatile("" ::: "memory");
        if (tid < 256) {
            const f32x4 t = *(const PG8_LAS f32x4*)(P + tid * 4);
            __hip_atomic_store(xs + ((size_t)(u.pm * BM + tid) * 8 + u.pn), (t[0] + t[1]) + (t[2] + t[3]), __ATOMIC_RELAXED, __HIP_MEMORY_SCOPE_AGENT);
        }
        asm volatile("s_waitcnt vmcnt(0)" ::: "memory");
        if (tid < 256 && lane == 0) __hip_atomic_fetch_add(cnt + 64 * u.pm, 1u, __ATOMIC_RELAXED, __HIP_MEMORY_SCOPE_AGENT);
        if (wid == 0) {
            unsigned spins = 0;
            while ((unsigned)__builtin_amdgcn_readfirstlane((int)__hip_atomic_load(cnt + 64 * u.pm, __ATOMIC_RELAXED, __HIP_MEMORY_SCOPE_AGENT)) < 32u) { __builtin_amdgcn_s_sleep(2); if (++spins > (1u << 22)) break; }
            __builtin_amdgcn_fence(__ATOMIC_ACQUIRE, "agent");
        }
        asm volatile("s_waitcnt vmcnt(0) lgkmcnt(0)" ::: "memory"); __builtin_amdgcn_s_barrier(); asm volatile("" ::: "memory");
        if (tid < 256) {
            const float* sl = xs + (size_t)(u.pm * BM + tid) * 8; float q = 0.f;
#pragma unroll
            for (int t = 0; t < 8; ++t) q += __hip_atomic_load(sl + t, __ATOMIC_RELAXED, __HIP_MEMORY_SCOPE_AGENT);
            S[tid] = rsqrtf(q * (1.0f / DM) + EPS);
        }
        asm volatile("s_waitcnt lgkmcnt(0)" ::: "memory"); __builtin_amdgcn_s_barrier(); asm volatile("" ::: "memory");
        f32x4 gv[2][2];
#pragma unroll
        for (int bj = 0; bj < 2; ++bj)
#pragma unroll
            for (int n = 0; n < 2; ++n) gv[bj][n] = *(const f32x4*)(gain + col0 + bj * HALF + 4 * n);
#pragma unroll
        for (int ai = 0; ai < 2; ++ai)
#pragma unroll
            for (int m = 0; m < 4; ++m) {
                const int rl = rl0 + ai * HALF + m * 16; const size_t off = (size_t)(u.pm * BM + rl) * DM + col0; const float rs = S[rl];
#pragma unroll
                for (int bj = 0; bj < 2; ++bj) { *(f32x4*)(out + off + bj * HALF) = acc[ai][bj][m][0] * rs * gv[bj][0]; *(f32x4*)(out + off + bj * HALF + 4) = acc[ai][bj][m][1] * rs * gv[bj][1]; }
            }
    }
};
}

namespace att {
constexpr int KB0 = 0, VB0 = 32768, TILEB = 16384, WSC = 65536, RELB = 67584, GQK = 68608, KSC = 69632, DONE = 70656;
__device__ __forceinline__ unsigned off_b(unsigned row, unsigned ch) { return 256u * row + 16u * (ch ^ (((row & 3) << 2) | ((row >> 2) & 3))); }
struct Addr { unsigned kb[8]; unsigned vb[2][4]; };
__device__ __forceinline__ void addr_init(Addr& a, int lane) {
    const unsigned r32 = lane & 31, hi = lane >> 5, xr = ((r32 & 3) << 2) | ((r32 >> 2) & 3);
#pragma unroll
    for (int s = 0; s < 8; ++s) a.kb[s] = 256u * r32 + 16u * ((2u * s + hi) ^ xr);
    const unsigned blk = (lane >> 4) & 1, q = (lane & 15) >> 2, p = lane & 3, cl = 2 * blk + (p >> 1), R0 = 4 * hi + q;
#pragma unroll
    for (int t = 0; t < 2; ++t)
#pragma unroll
        for (int c = 0; c < 4; ++c) a.vb[t][c] = 256u * R0 + 64u * ((unsigned)c ^ q) + 16u * (cl ^ (2u * t + hi)) + 8u * (p & 1);
}
template <int SUB> __device__ __forceinline__ f32x16 qk_sub(ldsp Kb, const Addr& a, const bf16x8 (&qr)[8]) {
    f32x16 p = {};
#pragma unroll
    for (int s = 0; s < 8; ++s) { const bf16x8 kf = *(const LAS bf16x8*)(Kb + a.kb[s] + 8192 * SUB); p = __builtin_amdgcn_mfma_f32_32x32x16_bf16(kf, qr[s], p, 0, 0, 0); }
    return p;
}
__device__ __forceinline__ s16x4 vtr(ldsp p) { return __builtin_bit_cast(s16x4, __builtin_amdgcn_ds_read_tr16_b64_v4i16((LAS s16x4*)p)); }
template <int SUB> __device__ __forceinline__ void pv_sub(f32x16 (&o)[4], ldsp Vb, const Addr& a, const f32x16& p) {
    u32x4 w0, w1;
    w0.x = pk2(p[0], p[1]); w0.y = pk2(p[2], p[3]); w0.z = pk2(p[4], p[5]); w0.w = pk2(p[6], p[7]);
    w1.x = pk2(p[8], p[9]); w1.y = pk2(p[10], p[11]); w1.z = pk2(p[12], p[13]); w1.w = pk2(p[14], p[15]);
    const bf16x8 pa0 = __builtin_bit_cast(bf16x8, w0), pa1 = __builtin_bit_cast(bf16x8, w1);
#pragma unroll
    for (int c = 0; c < 4; ++c)
#pragma unroll
        for (int ks = 0; ks < 2; ++ks) {
            const s16x4 lo = vtr(Vb + a.vb[0][c] + 256 * (32 * SUB + 16 * ks)), hi4 = vtr(Vb + a.vb[1][c] + 256 * (32 * SUB + 16 * ks + 8));
            const bf16x8 vf = {lo[0], lo[1], lo[2], lo[3], hi4[0], hi4[1], hi4[2], hi4[3]};
            o[c] = __builtin_amdgcn_mfma_f32_32x32x16_bf16(ks ? pa1 : pa0, vf, o[c], 0, 0, 0);
        }
}
template <bool MASK> __device__ __forceinline__ void sb_sub(f32x16& p, float& carry, int srel, int hi) {
    float L[16];
#pragma unroll
    for (int r = 0; r < 16; ++r) {
        const float z = p[r];
        const float lg = __builtin_amdgcn_logf(1.0f + __builtin_amdgcn_exp2f(-__builtin_fabsf(z)));
        float l = -(__builtin_fmaxf(z, 0.f) + lg);
        if (MASK && (srel + (r & 3) + 8 * (r >> 2) >= 0)) l = 0.f;
        L[r] = l;
    }
    float gs[4], go[4], suf[4];
#pragma unroll
    for (int g = 0; g < 4; ++g) { gs[g] = (L[4 * g] + L[4 * g + 1]) + (L[4 * g + 2] + L[4 * g + 3]); go[g] = __shfl_xor(gs[g], 32); }
    suf[3] = carry; suf[2] = suf[3] + (gs[3] + go[3]); suf[1] = suf[2] + (gs[2] + go[2]); suf[0] = suf[1] + (gs[1] + go[1]); carry = suf[0] + (gs[0] + go[0]);
#pragma unroll
    for (int g = 0; g < 4; ++g) {
        float incl = suf[g] + (hi ? 0.f : go[g]);
#pragma unroll
        for (int e = 3; e >= 0; --e) {
            const int r = 4 * g + e; incl += L[r];
            float w = __builtin_amdgcn_exp2f(p[r] + incl);
            if (MASK && (srel + (r & 3) + 8 * (r >> 2) >= 0)) w = 0.f;
            p[r] = w;
        }
    }
}
__device__ __forceinline__ void store_o(const f32x16 (&o)[4], ldsp stg, bf16* Og  , int lane) {
    asm volatile("" : "+v"(lane));
    const int r32 = lane & 31, hi = lane >> 5;
#pragma unroll
    for (int c = 0; c < 4; ++c)
#pragma unroll
        for (int r = 0; r < 16; ++r) { const int row = (r & 3) + 8 * (r >> 2) + 4 * hi; *(LAS bf16*)(stg + row * 256 + (32 * c + r32) * 2) = (bf16)(pk2(o[c][r], 0.f) & 0xffffu); }
    asm volatile("s_waitcnt lgkmcnt(0)" ::: "memory");
#pragma unroll
    for (int i = 0; i < 8; ++i) { const int row = 4 * i + (lane >> 4), ch = lane & 15; const u32x4 v = *(const LAS u32x4*)(stg + row * 256 + ch * 16); *(u32x4*)(Og + (size_t)row * QP + ch * 8) = v; }
}

__device__ __forceinline__ void sb_unit(int b, int h, int qb, const bf16* Q, const bf16* K, const bf16* V, bf16* O, ldsp lds, const Addr& ad) {
    const int tid = threadIdx.x, lane = tid & 63, r32 = lane & 31, hi = lane >> 5, wid = __builtin_amdgcn_readfirstlane(tid >> 6);
    const int q0 = qb * 256, wmin = q0 + 32 * wid, tq = wmin + r32;
    const size_t rowbase = (size_t)b * SEQ;
    bf16x8 qr[8];
    { const bf16* qp = Q + (rowbase + tq) * QP + h * 128 + hi * 8;
#pragma unroll
      for (int s = 0; s < 8; ++s) qr[s] = *(const bf16x8*)(qp + 16 * s); }
    f32x16 o[4];
#pragma unroll
    for (int c = 0; c < 4; ++c) o[c] = (f32x16){};
    float carry = 0.f;
    const int NT = (q0 + 256) / 64;
    const bf16* Kh = K + rowbase * HW + h * 128; const bf16* Vh = V + rowbase * HW + h * 128;
    unsigned dgo[2];
#pragma unroll
    for (int i = 0; i < 2; ++i) { const unsigned piece = 2 * wid + i, row = 4 * piece + (lane >> 4), xr = (((unsigned)lane >> 4) << 2) | (piece & 3); dgo[i] = row * HW + (((unsigned)lane & 15) ^ xr) * 8; }
#define SB_DMA(kt, buf) do { const bf16* kp_ = Kh + (size_t)(kt) * 64 * HW; const bf16* vp_ = Vh + (size_t)(kt) * 64 * HW; \
        _Pragma("unroll") for (int i_ = 0; i_ < 2; ++i_) { \
            __builtin_amdgcn_global_load_lds((const unsigned*)(kp_ + dgo[i_]), (LAS unsigned*)(lds + KB0 + (buf) * TILEB + (2 * wid + i_) * 1024), 16, 0, 0); \
            __builtin_amdgcn_global_load_lds((const unsigned*)(vp_ + dgo[i_]), (LAS unsigned*)(lds + VB0 + (buf) * TILEB + (2 * wid + i_) * 1024), 16, 0, 0); } } while (0)
    LAS int* doneAt = (LAS int*)(lds + DONE);
    if (tid < 8) doneAt[tid] = 0x7fffffff;
    bool wdone = false;
    SB_DMA(NT - 1, 0); __syncthreads();
    for (int it = 0; it < NT; ++it) {
        const int kt = NT - 1 - it, cur = it & 1;
        if (it + 1 < NT) SB_DMA(kt - 1, cur ^ 1);
        const int k0 = 64 * kt;
        if (!wdone && k0 < wmin + 31) {
            ldsp Kb = lds + KB0 + cur * TILEB, Vb = lds + VB0 + cur * TILEB;
            if (k0 + 32 < wmin + 31) {
                f32x16 p = qk_sub<1>(Kb, ad, qr);
                const int srel = k0 + 32 + 4 * hi - tq;
                if (k0 + 63 >= wmin) sb_sub<true>(p, carry, srel, hi); else sb_sub<false>(p, carry, srel, hi);
                pv_sub<1>(o, Vb, ad, p);
            }
            {
                f32x16 p = qk_sub<0>(Kb, ad, qr);
                const int srel = k0 + 4 * hi - tq;
                if (k0 + 31 >= wmin) sb_sub<true>(p, carry, srel, hi); else sb_sub<false>(p, carry, srel, hi);
                pv_sub<0>(o, Vb, ad, p);
            }
            if (__all(carry < -150.0f)) { wdone = true; if (lane == 0) doneAt[wid] = it; }
        }
        __syncthreads();
        { const LAS u32x4* dp = (const LAS u32x4*)doneAt; const u32x4 d0 = dp[0], d1 = dp[1];
          int mxd = (int)d0.x; mxd = max(mxd, (int)d0.y); mxd = max(mxd, (int)d0.z); mxd = max(mxd, (int)d0.w); mxd = max(mxd, (int)d1.x); mxd = max(mxd, (int)d1.y); mxd = max(mxd, (int)d1.z); mxd = max(mxd, (int)d1.w);
          if (__builtin_amdgcn_readfirstlane(mxd) <= it) break; }
    }
#undef SB_DMA
    store_o(o, lds + wid * 8192, O + (rowbase + wmin) * QP + h * 128, lane);
    __syncthreads();
}

__device__ __forceinline__ void ca_unit(int b, int h, int cb, const bf16* Q, const bf16* K, const bf16* V, bf16* O, const float* qkss,
                                        const float* gq, const float* gk, const float* relbias, ldsp lds, const Addr& ad) {
    const int tid = threadIdx.x, lane = tid & 63, r32 = lane & 31, hi = lane >> 5, wid = __builtin_amdgcn_readfirstlane(tid >> 6);
    const int c0 = cb * 4, cw = c0 + (wid >> 1), irow = 32 * (wid & 1) + r32, tq = 64 * cw + irow;
    const size_t rowbase = (size_t)b * SEQ;
    LAS float* relb = (LAS float*)(lds + RELB); LAS float* gqk = (LAS float*)(lds + GQK); LAS float* ksc = (LAS float*)(lds + KSC);
    LAS float* wsf = (LAS float*)(lds + WSC) + wid * 64;
    { int t2 = tid; asm volatile("" : "+v"(t2));
      if (t2 < 192) relb[t2] = relbias[h * 192 + t2] * LOG2E;
      if (t2 >= 256 && t2 < 384) { const int d = t2 - 256; gqk[d] = gq[d] * gk[d] * C2; } }
    __syncthreads();
    bf16x8 qr[8];
    { const f32x4 pq = *(const f32x4*)(qkss + (rowbase + tq) * 64 + h * 4);
      const float rq = rsqrtf(((pq[0] + pq[1]) + (pq[2] + pq[3])) * (1.0f / 128.0f) + EPS);
      const bf16* qp = Q + (rowbase + tq) * QP + h * 128 + hi * 8;
#pragma unroll
      for (int s = 0; s < 8; ++s) {
          const u32x4 raw = *(const u32x4*)(qp + 16 * s); const LAS float* g = gqk + 16 * s + 8 * hi;
          u32x4 w; w.x = pk2(bflo(raw.x) * rq * g[0], bfhi(raw.x) * rq * g[1]); w.y = pk2(bflo(raw.y) * rq * g[2], bfhi(raw.y) * rq * g[3]);
          w.z = pk2(bflo(raw.z) * rq * g[4], bfhi(raw.z) * rq * g[5]); w.w = pk2(bflo(raw.w) * rq * g[6], bfhi(raw.w) * rq * g[7]);
          qr[s] = __builtin_bit_cast(bf16x8, w);
      } }
    f32x16 o[4];
#pragma unroll
    for (int c = 0; c < 4; ++c) o[c] = (f32x16){};
    float mrun = -1e30f, lrun = 0.f;
    const int kc0 = (c0 - 8 > 0) ? c0 - 8 : 0, NT = c0 + 4 - kc0;
    const bf16* Kh = K + rowbase * HW + h * 128; const bf16* Vh = V + rowbase * HW + h * 128;
    unsigned dgo[2];
#pragma unroll
    for (int i = 0; i < 2; ++i) { const unsigned piece = 2 * wid + i, row = 4 * piece + (lane >> 4), xr = (((unsigned)lane >> 4) << 2) | (piece & 3); dgo[i] = row * HW + (((unsigned)lane & 15) ^ xr) * 8; }
    f32x4 kpr = {1.f, 1.f, 1.f, 1.f};
#define CA_DMA(kc, buf) do { const bf16* kp_ = Kh + (size_t)(kc) * 64 * HW; const bf16* vp_ = Vh + (size_t)(kc) * 64 * HW; \
        _Pragma("unroll") for (int i_ = 0; i_ < 2; ++i_) { \
            __builtin_amdgcn_global_load_lds((const unsigned*)(kp_ + dgo[i_]), (LAS unsigned*)(lds + KB0 + (buf) * TILEB + (2 * wid + i_) * 1024), 16, 0, 0); \
            __builtin_amdgcn_global_load_lds((const unsigned*)(vp_ + dgo[i_]), (LAS unsigned*)(lds + VB0 + (buf) * TILEB + (2 * wid + i_) * 1024), 16, 0, 0); } \
        if (tid < 64) kpr = *(const f32x4*)(qkss + (rowbase + (size_t)(kc) * 64 + tid) * 64 + (8 + h) * 4); } while (0)
#define CA_KSC(buf) do { if (tid < 64) ksc[(buf) * 64 + tid] = rsqrtf(((kpr[0] + kpr[1]) + (kpr[2] + kpr[3])) * (1.0f / 128.0f) + EPS); } while (0)
    CA_DMA(kc0, 0); CA_KSC(0); __syncthreads();
    for (int it = 0; it < NT; ++it) {
        const int kc = kc0 + it, cur = it & 1;
        if (it + 1 < NT) CA_DMA(kc + 1, cur ^ 1);
        const int jc = kc - (cw - 8);
        if (jc >= 0 && jc <= 8) {
            ldsp Kb = lds + KB0 + cur * TILEB, Vb = lds + VB0 + cur * TILEB;
            const LAS float* kscb = ksc + cur * 64 + 4 * hi;
            const int dbase = irow + 64 * (8 - jc) - 4 * hi;
#define CA_SUB(SUB) do { \
            f32x16 p = qk_sub<SUB>(Kb, ad, qr); \
            if (jc <= 5) { const float bc = relb[191]; \
                _Pragma("unroll") for (int g = 0; g < 4; ++g) { const f32x4 s0 = *(const LAS f32x4*)(kscb + 32 * SUB + 8 * g); \
                    _Pragma("unroll") for (int e = 0; e < 4; ++e) p[4 * g + e] = p[4 * g + e] * s0[e] + bc; } \
            } else { \
                _Pragma("unroll") for (int g = 0; g < 4; ++g) { const f32x4 s0 = *(const LAS f32x4*)(kscb + 32 * SUB + 8 * g); \
                    _Pragma("unroll") for (int e = 0; e < 4; ++e) { const int d0 = dbase - (32 * SUB + 8 * g + e); p[4 * g + e] = p[4 * g + e] * s0[e] + relb[(d0 < 128 ? d0 : 128) + 63]; } } \
            } \
            float mx = p[0]; \
            _Pragma("unroll") for (int r = 1; r < 16; ++r) mx = __builtin_fmaxf(mx, p[r]); \
            mx = __builtin_fmaxf(mx, __shfl_xor(mx, 32)); \
            const float mnew = __builtin_fmaxf(mrun, mx); \
            if (__any(mnew > mrun)) { \
                const float alpha = __builtin_amdgcn_exp2f(mrun - mnew); lrun *= alpha; mrun = mnew; \
                if (hi == 0) wsf[r32] = alpha; \
                asm volatile("s_waitcnt lgkmcnt(0)" ::: "memory"); \
                _Pragma("unroll") for (int g = 0; g < 4; ++g) { const f32x4 al = *(const LAS f32x4*)(wsf + 8 * g + 4 * hi); \
                    _Pragma("unroll") for (int c = 0; c < 4; ++c) _Pragma("unroll") for (int e = 0; e < 4; ++e) o[c][4 * g + e] *= al[e]; } \
            } \
            float ps = 0.f; \
            _Pragma("unroll") for (int r = 0; r < 16; ++r) { p[r] = __builtin_amdgcn_exp2f(p[r] - mrun); ps += p[r]; } \
            lrun += ps; \
            pv_sub<SUB>(o, Vb, ad, p); } while (0)
            CA_SUB(0); CA_SUB(1);
#undef CA_SUB
        }
        if (it + 1 < NT) CA_KSC(cur ^ 1);
        __syncthreads();
    }
#undef CA_DMA
#undef CA_KSC
    { const float lt = lrun + __shfl_xor(lrun, 32);
      if (hi == 0) wsf[r32] = __builtin_amdgcn_rcpf(lt);
      asm volatile("s_waitcnt lgkmcnt(0)" ::: "memory");
#pragma unroll
      for (int g = 0; g < 4; ++g) { const f32x4 al = *(const LAS f32x4*)(wsf + 8 * g + 4 * hi);
#pragma unroll
          for (int c = 0; c < 4; ++c)
#pragma unroll
              for (int e = 0; e < 4; ++e) o[c][4 * g + e] *= al[e]; } }
    store_o(o, lds + wid * 8192, O + (rowbase + 64 * cw + 32 * (wid & 1)) * QP + h * 128, lane);
    __syncthreads();
}
}

#define RLX_AGENT __ATOMIC_RELAXED, __HIP_MEMORY_SCOPE_AGENT
#define XB_TMO      128
#define XB_XCNT(j)  (256  + 64 * (j))
#define XB_XSUB(j)  (1280 + 64 * (j))
#define XB_XGEN(j)  (2304 + 64 * (j))
#define XB_TOP      3328
#define XB_TOPGEN   3392
#define XCD_BAR_WORDS 3456
#define XB_SPIN_CAP (1u << 18)

__device__ __forceinline__ unsigned xb_ld(unsigned* p)              { return __hip_atomic_load(p, __ATOMIC_RELAXED, __HIP_MEMORY_SCOPE_AGENT); }
__device__ __forceinline__ unsigned xb_add(unsigned* p, unsigned v) { return __hip_atomic_fetch_add(p, v, __ATOMIC_RELAXED, __HIP_MEMORY_SCOPE_AGENT); }
__device__ __forceinline__ unsigned xb_xcc_id() { return (unsigned)__builtin_amdgcn_s_getreg((3 << 11) | 20) & 0xFu; }
#define XB_SPIN(cond, bar) do { unsigned _sp = 0; while (cond) { __builtin_amdgcn_s_sleep(1); \
    if ((++_sp & 255u) == 0u) { if (xb_ld(&(bar)[XB_TMO])) break; if (_sp > XB_SPIN_CAP) { atomicAdd(&(bar)[XB_TMO], 1u); break; } } } } while (0)

struct XcdBarrier {
    unsigned* bar; unsigned x;
    volatile LAS unsigned* st;
};

__device__ __forceinline__ XcdBarrier xcd_barrier_post(unsigned* bar, volatile LAS unsigned* st) {
    XcdBarrier b; b.bar = bar; b.x = xb_xcc_id(); b.st = st;
    if (threadIdx.x == 0) (void)xb_add(&bar[XB_XCNT(b.x)], 1u);
    return b;
}
__device__ __forceinline__ void xcd_barrier_complete(unsigned* bar, unsigned x, unsigned& nloc, unsigned& nx) {
    const unsigned G = gridDim.x * gridDim.y * gridDim.z;
    unsigned sum, cnt, mine, sp = 0u;
    for (;;) {
        sum = 0u; cnt = 0u; mine = 0u;
#pragma unroll
        for (unsigned j = 0; j < 16; ++j) { const unsigned c = xb_ld(&bar[XB_XCNT(j)]); sum += c; cnt += (c > 0u) ? 1u : 0u; mine = (j == x) ? c : mine; }
        if (sum == G) break;
        __builtin_amdgcn_s_sleep(1);
        if ((++sp & 255u) == 0u) { if (xb_ld(&bar[XB_TMO])) break; if (sp > XB_SPIN_CAP) { atomicAdd(&bar[XB_TMO], 1u); break; } }
    }
    nloc = mine > 0u ? mine : 1u; nx = cnt > 0u ? cnt : 1u;
}

__device__ __forceinline__ void xcd_barrier(const XcdBarrier& b) {
    asm volatile("s_waitcnt vmcnt(0)" ::: "memory");
    __syncthreads();
    if (threadIdx.x == 0) {
        unsigned* bar = b.bar;
        __builtin_amdgcn_s_waitcnt(0);
        unsigned nloc = b.st[0], nx = b.st[1];
        if (nloc == 0u) { xcd_barrier_complete(bar, b.x, nloc, nx); b.st[0] = nloc; b.st[1] = nx; }
        const unsigned old = xb_add(&bar[XB_XSUB(b.x)], 1u);
        const unsigned gen = old / nloc;
        if (old + 1u == (gen + 1u) * nloc) {
            __builtin_amdgcn_fence(__ATOMIC_RELEASE, "agent");
            asm volatile("s_waitcnt vmcnt(0)" ::: "memory");
            const unsigned og = xb_add(&bar[XB_TOP], 1u);
            const unsigned tg = og / nx;
            if (og + 1u == (tg + 1u) * nx) xb_add(&bar[XB_TOPGEN], 1u);
            else XB_SPIN(xb_ld(&bar[XB_TOPGEN]) == tg, bar);
            __builtin_amdgcn_fence(__ATOMIC_ACQUIRE, "agent");
            xb_add(&bar[XB_XGEN(b.x)], 1u);
            asm volatile("s_waitcnt vmcnt(0)" ::: "memory");
        } else {
            XB_SPIN(xb_ld(&bar[XB_XGEN(b.x)]) == gen, bar);
            __builtin_amdgcn_fence(__ATOMIC_ACQUIRE, "agent");
            asm volatile("s_waitcnt vmcnt(0)" ::: "memory");
        }
    }
    __syncthreads();
}

constexpr int NWAVES = 8, NTHREADS = 512;
constexpr int LDS_BYTES = 147456;
constexpr size_t MiB = 1u << 20;
constexpr size_t WS_SSA = 1 * MiB, WS_SSB = 3 * MiB, WS_QKSS = 5 * MiB;
constexpr size_t WS_WIN = 10 * MiB, WS_WOA = 50 * MiB, WS_WOB = 54 * MiB, WS_WOUT = 58 * MiB;
constexpr size_t WS_W2GU = 66 * MiB, WS_W2D = 110 * MiB, WS_XB = 66 * MiB;
constexpr size_t WS_W1GU = 132 * MiB, WS_W1D = 176 * MiB, WS_QSB = 132 * MiB, WS_QCA = 164 * MiB, WS_X2B = 132 * MiB;
constexpr size_t WS_H = 198 * MiB, WS_KSB = 198 * MiB, WS_VSB = 230 * MiB, WS_KCA = 262 * MiB, WS_VCA = 294 * MiB, WS_G = 198 * MiB, WS_GATES = 326 * MiB;
constexpr size_t WS_END = 454 * MiB;
constexpr int NPH = 9;

__device__ __forceinline__ float wave_sum(float v) {
#pragma unroll
    for (int o = 1; o < 64; o <<= 1) v += __shfl_xor(v, o);
    return v;
}
__device__ __forceinline__ void tr_item(const float* W, int N, int K, bf16* WT, int k0, int n0, int drow0, const float* gain, LAS float* scr, int lane, int blk_nt = 0) {
    const int ko = lane >> 3, nq = lane & 7;
    const float* src = W + (size_t)(k0 + 8 * ko) * N + n0 + 4 * nq;
    f32x4 v[8];
#pragma unroll
    for (int j = 0; j < 8; ++j) v[j] = __builtin_nontemporal_load((const f32x4*)(src + (size_t)j * N));
    if (gain) { const f32x4 g0 = *(const f32x4*)(gain + k0 + 8 * ko), g1 = *(const f32x4*)(gain + k0 + 8 * ko + 4);
#pragma unroll
        for (int j = 0; j < 4; ++j) { v[j] = v[j] * g0[j]; v[4 + j] = v[4 + j] * g1[j]; } }
    const int nrow = drow0 + 4 * nq;
    bf16* dst = blk_nt ? WT + ((size_t)(nrow >> 8) * blk_nt + (k0 >> 6)) * 16384 + (size_t)(nrow & 255) * 64 + 8 * ko : WT + (size_t)nrow * K + k0 + 8 * ko;
    const size_t rstride = blk_nt ? 64 : (size_t)K;
#pragma unroll
    for (int i = 0; i < 4; ++i) { u32x4 o; o.x = pk2(v[0][i], v[1][i]); o.y = pk2(v[2][i], v[3][i]); o.z = pk2(v[4][i], v[5][i]); o.w = pk2(v[6][i], v[7][i]);
        *(u32x4*)(dst + (size_t)i * rstride) = o; }
}
__device__ __forceinline__ void tr_plain(const float* W, int K, int N, bf16* WT, const float* gain, LAS float* scr, int item, int lane, int pitch = 0, bool blk = false) {
    const int nblk = N / 32, kb = item / nblk, nb = item % nblk; tr_item(W, N, pitch ? pitch : K, WT, 64 * kb, 32 * nb, 32 * nb, gain, scr, lane, blk ? K / 64 : 0);
}
__device__ __forceinline__ void tr_gu(const float* Wg, const float* Wu, bf16* WT, const float* gain, LAS float* scr, int item, int lane) {
    constexpr int nblk = DFF / 32, per = (DM / 64) * nblk; const int mat = item / per, r = item % per, kb = r / nblk, n0 = 32 * (r % nblk);
    tr_item(mat ? Wu : Wg, DFF, DM, WT, 64 * kb, n0, 256 * (n0 >> 7) + 128 * mat + (n0 & 127), gain, scr, lane);
}

struct Args { const float* in[19]; float* out; unsigned char* ws; int ph_lo, ph_hi; };
static_assert(sizeof(Args) == 19 * 8 + 8 + 8 + 8, "Args has no padding");

__global__ void __launch_bounds__(NTHREADS, 2) fwd(Args args) {
    extern __shared__ __attribute__((aligned(16))) unsigned char lds_raw[];
    ldsp lds = (ldsp)lds_raw;
    const int tid = threadIdx.x, lane = tid & 63, wave = __builtin_amdgcn_readfirstlane(tid >> 6);
    const int G = gridDim.x, bx = blockIdx.x, vcu = (G % 8 == 0) ? (bx % 8) * (G / 8) + bx / 8 : bx;
    unsigned char* ws = args.ws;
    const float* x = args.in[0]; float* X = args.out;
#define ssA ((float*)(ws + WS_SSA))
#define ssB ((float*)(ws + WS_SSB))
#define qkss ((float*)(ws + WS_QKSS))
#define Win ((bf16*)(ws + WS_WIN))
#define WoA ((bf16*)(ws + WS_WOA))
#define WoB ((bf16*)(ws + WS_WOB))
#define Wout ((bf16*)(ws + WS_WOUT))
#define W2gu ((bf16*)(ws + WS_W2GU))
#define W2d ((bf16*)(ws + WS_W2D))
#define XB ((bf16*)(ws + WS_XB))
#define W1gu ((bf16*)(ws + WS_W1GU))
#define W1d ((bf16*)(ws + WS_W1D))
#define QSB ((bf16*)(ws + WS_QSB))
#define QCA (QSB + HW)
#define X2B ((bf16*)(ws + WS_X2B))
#define Hb ((bf16*)(ws + WS_H))
#define KSB ((bf16*)(ws + WS_KSB))
#define VSB ((bf16*)(ws + WS_VSB))
#define KCA ((bf16*)(ws + WS_KCA))
#define VCA ((bf16*)(ws + WS_VCA))
#define Gm ((bf16*)(ws + WS_G))
#define GATES ((bf16*)(ws + WS_GATES))
    const int lo = args.ph_lo, hi = args.ph_hi;
    cg::grid_group grid = cg::this_grid();
    volatile LAS unsigned* MISC = (volatile LAS unsigned*)(lds + 131072);
    if (tid < 64) MISC[tid] = 0u;
    __syncthreads();
    XcdBarrier xbar; xbar.bar = (unsigned*)ws; xbar.x = 0; xbar.st = MISC + 8;
    if (hi - lo > 1) xbar = xcd_barrier_post((unsigned*)ws, MISC + 8);
    if (lo < 0) grid.sync();
#ifndef PH_MASK
#define PH_MASK 0x3ff
#endif
#define IN(k) (((PH_MASK >> (k)) & 1) && lo <= (k) && (k) < hi)
#define SEAM(k) do { if (IN(k) && IN((k) + 1)) xcd_barrier(xbar); } while (0)
    const int gw = vcu * NWAVES + wave, NGW = G * NWAVES;
    LAS float* scr = (LAS float*)(lds + wave * 16384);

    if (IN(0)) {
        constexpr int I_GU = 2 * (DM / 64) * (DFF / 32), I_D = (DFF / 64) * (DM / 32), I_IN = (DM / 64) * (NIN / 32), I_O = (HW / 64) * (DM / 32), I_OUT = (DM / 64) * (DM / 32);
        constexpr int NITEMS = I_GU + I_D + I_IN + 2 * I_O + I_OUT;
        for (int it = gw; it < NITEMS; it += NGW) {
            int r = it;
            if (r < I_GU) { tr_gu(args.in[2], args.in[3], W1gu, args.in[1], scr, r, lane); continue; } r -= I_GU;
            if (r < I_D) { tr_plain(args.in[4], DFF, DM, W1d, nullptr, scr, r, lane, 0, true); continue; } r -= I_D;
            if (r < I_IN) { tr_plain(args.in[6], DM, NIN, Win, args.in[5], scr, r, lane); continue; } r -= I_IN;
            if (r < I_O) { tr_plain(args.in[11], HW, DM, WoA, nullptr, scr, r, lane, 2 * HW); continue; } r -= I_O;
            if (r < I_O) { tr_plain(args.in[12], HW, DM, WoA + HW, nullptr, scr, r, lane, 2 * HW); continue; } r -= I_O;
            tr_plain(args.in[13], DM, DM, Wout, nullptr, scr, r, lane);
        }
        for (int m = gw; m < M; m += NGW) {
            const f32x4* xr = (const f32x4*)(x + (size_t)m * DM) + lane; f32x4 v[8]; float s = 0.f;
#pragma unroll
            for (int j = 0; j < 8; ++j) { v[j] = xr[64 * j]; s += (v[j][0] * v[j][0] + v[j][1] * v[j][1]) + (v[j][2] * v[j][2] + v[j][3] * v[j][3]); }
            s = wave_sum(s);
            u32x2* o8 = (u32x2*)(XB + (size_t)m * DM) + lane;
#pragma unroll
            for (int j = 0; j < 8; ++j) { u32x2 w; w.x = pk2(v[j][0], v[j][1]); w.y = pk2(v[j][2], v[j][3]); o8[64 * j] = w; }
            if (lane < NSS) ssA[(size_t)m * NSS + lane] = (lane == 0) ? s : 0.f;
        }
    }
    SEAM(0);
    if (IN(1)) {
        pg8::Gemm g{XB, W1gu, M, 2 * DFF, DM}; pg8::StaticOrder S; S.init(M, 2 * DFF, G, bx);
        pg8::EpiSwiglu E{Hb, ssA};
        pg8::gemm_phase<pg8::EpiSwiglu, pg8::StaticOrder, true, true>(lds, g, S, E);
    }
    SEAM(1);
    if (IN(2)) {
        pg8::Gemm g{Hb, W1d, M, DM, DFF, true, true}; pg8::StaticOrder S; S.init(M, DM, G, bx);
        pg8::EpiResid<false> E{x, nullptr, (bf16*)X, ssB, 0.5f};
        pg8::gemm_phase<pg8::EpiResid<false>, pg8::StaticOrder, true, true>(lds, g, S, E);
    }
    SEAM(2);
    if (IN(3)) {
        pg8::Gemm g{(const bf16*)X, Win, M, NIN, DM}; pg8::StaticOrder S; S.init(M, NIN, G, bx);
        pg8::EpiIn E{QSB, KSB, VSB, QCA, KCA, VCA, GATES, qkss, ssB, args.in[7]};
        pg8::gemm_phase<pg8::EpiIn, pg8::StaticOrder, true, true>(lds, g, S, E);
    }
    SEAM(3);
    if (IN(4)) {
        att::Addr ad; att::addr_init(ad, lane);
        constexpr int I_GU = 2 * (DM / 64) * (DFF / 32), I_D = (DFF / 64) * (DM / 32);
        const int cslot = vcu % 3;
#define W2_COPIES() do { for (int it = gw; it < I_GU + I_D; it += NGW) { \
            if (it < I_GU) tr_gu(args.in[15], args.in[16], W2gu, args.in[14], scr, it, lane); \
            else tr_plain(args.in[17], DFF, DM, W2d, nullptr, scr, it - I_GU, lane, 0, true); } } while (0)
        if (cslot == 0) W2_COPIES();
        for (int u = vcu; u < 256; u += G) {
            const int bh = u >> 3, s = u & 7;
            att::sb_unit(bh >> 3, bh & 7, s, QSB, KSB, VSB, QSB, lds, ad);
            att::sb_unit(bh >> 3, bh & 7, 15 - s, QSB, KSB, VSB, QSB, lds, ad);
        }
        if (cslot == 1) W2_COPIES();
        for (int u = vcu; u < 512; u += G) {
            const int bh = u >> 4;
            att::ca_unit(bh >> 3, bh & 7, u & 15, QCA, KCA, VCA, QCA, qkss, args.in[8], args.in[9], args.in[10], lds, ad);
        }
        if (cslot == 2) W2_COPIES();
#undef W2_COPIES
    }
    SEAM(4);
    if (IN(5)) {
        pg8::Gemm g{QSB, WoA, M, DM, 2 * HW}; pg8::StaticOrder S; S.init(M, DM, G, bx); pg8::EpiGateF E{GATES, Gm};
        pg8::gemm_phase<pg8::EpiGateF, pg8::StaticOrder, true, true>(lds, g, S, E);
    }
    SEAM(5);
    if (IN(6)) {
        pg8::Gemm g{Gm, Wout, M, DM, DM}; pg8::StaticOrder S; S.init(M, DM, G, bx);
        pg8::EpiResid<true> E{(const bf16*)X, nullptr, X2B, ssA, 1.0f};
        pg8::gemm_phase<pg8::EpiResid<true>, pg8::StaticOrder, true, true>(lds, g, S, E);
    }
    SEAM(6);
    if (IN(7)) {
        pg8::Gemm g{X2B, W2gu, M, 2 * DFF, DM}; pg8::StaticOrder S; S.init(M, 2 * DFF, G, bx);
        pg8::EpiSwiglu E{Hb, ssA};
        pg8::gemm_phase<pg8::EpiSwiglu, pg8::StaticOrder, true, true>(lds, g, S, E);
    }
    SEAM(7);
    if (IN(8)) {
        pg8::Gemm g{Hb, W2d, M, DM, DFF, true, true};
        pg8::PanelOrder S; S.init(bx);
        pg8::EpiFinal E{X2B, X, args.in[18], (float*)(ws + 512 * 1024), (unsigned*)(ws + 32 * 1024), lds + 132096, 0.5f};
        pg8::gemm_phase<pg8::EpiFinal, pg8::PanelOrder, true, true>(lds, g, S, E);
    }
#undef IN
#undef SEAM
}

extern "C" void kernel_launch(void* const* d_in, const int* in_sizes, int n_in, void* d_out, int out_size, void* d_ws, size_t ws_size, hipStream_t stream) {
    static int grid = 0;
    if (grid == 0) {
        if (n_in != 19 || in_sizes[0] != M * DM || out_size != M * DM || ws_size < WS_END) { fprintf(stderr, "kernel_launch: unexpected shapes / workspace (n_in %d, ws %zu)\n", n_in, ws_size); grid = -1; return; }
        int dev = 0, cus = 0, per_cu = 0;
        if (hipGetDevice(&dev) != hipSuccess || hipDeviceGetAttribute(&cus, hipDeviceAttributeMultiprocessorCount, dev) != hipSuccess) { grid = -1; return; }
        if (hipFuncSetAttribute((const void*)fwd, hipFuncAttributeMaxDynamicSharedMemorySize, LDS_BYTES) != hipSuccess) { fprintf(stderr, "kernel_launch: hipFuncSetAttribute failed\n"); grid = -1; return; }
        if (hipOccupancyMaxActiveBlocksPerMultiprocessor(&per_cu, (const void*)fwd, NTHREADS, LDS_BYTES) != hipSuccess || per_cu < 1) { fprintf(stderr, "kernel_launch: occupancy query gave %d\n", per_cu); per_cu = 1; }
        (void)hipGetLastError();
        grid = cus * per_cu;
        if (grid != 256) { fprintf(stderr, "kernel_launch: this kernel needs exactly 256 resident workgroups (one per CU of a 256-CU MI355X); got %d; nothing launched\n", grid); grid = -1; return; }
    }
    if (grid < 0) return;
    if (hipMemsetAsync(d_ws, 0, 65536, stream) != hipSuccess) { fprintf(stderr, "kernel_launch: memset failed\n"); return; }
    Args a{};
    for (int i = 0; i < 19; ++i) a.in[i] = (const float*)d_in[i];
    a.out = (float*)d_out; a.ws = (unsigned char*)d_ws;
#if MK_MULTI
    for (int p = 0; p < NPH; ++p) { a.ph_lo = p; a.ph_hi = p + 1; hipLaunchKernelGGL(fwd, dim3(grid), dim3(NTHREADS), LDS_BYTES, stream, a); }
#else
    a.ph_lo = 0; a.ph_hi = NPH;
    void* kargs[] = {&a};
    hipError_t e = hipLaunchCooperativeKernel((const void*)fwd, dim3(grid), dim3(NTHREADS), kargs, LDS_BYTES, stream);
    if (e != hipSuccess) fprintf(stderr, "kernel_launch: cooperative launch failed: %s (grid %d)\n", hipGetErrorString(e), grid);
#ifdef PROBE_EXTRA
    { static const int kExtra[] = {PROBE_EXTRA}; Args p = a; p.out = (float*)((unsigned char*)d_ws + WS_GATES);
      for (unsigned i = 0; i < sizeof(kExtra) / sizeof(kExtra[0]); ++i) { p.ph_lo = kExtra[i]; p.ph_hi = kExtra[i] + 1; hipLaunchKernelGGL(fwd, dim3(grid), dim3(NTHREADS), LDS_BYTES, stream, p); } }
#endif
#endif
}
```

```cpp
#include <hip/hip_runtime.h>
#include <hip/hip_cooperative_groups.h>
#include <cstdio>
#include <cstdint>
namespace cg = cooperative_groups;
#ifndef MK_MULTI
#define MK_MULTI 0
#endif
namespace pg8 {
#define PG8_LAS __attribute__((address_space(3)))
typedef unsigned short bf16_t;
typedef short bf16x8 __attribute__((ext_vector_type(8)));
typedef float f32x4 __attribute__((ext_vector_type(4)));
typedef unsigned u32x4 __attribute__((ext_vector_type(4)));
constexpr int BM = 256, BK = 64, HALF = 128, HTB = HALF * BK * 2  , STAGE_BYTES = 8 * HTB, NXCD = 8, WGM = 4;

__host__ __device__ __forceinline__ int lds_byte(int r, int c) { const int st = (r >> 4) * 2 + (c >> 5), rr = r & 15, cc = c & 31, ob = rr * 64 + cc * 2; return st * 1024 + (ob ^ (((ob >> 9) & 1) << 5)); }
__host__ __device__ __forceinline__ void stage_rc(int b, int& R, int& C) { const int st = b / 1024, sb = b % 1024, swz = sb ^ (((sb >> 9) & 1) << 5); R = (st >> 1) * 16 + swz / 64; C = (st & 1) * 32 + (swz % 64) / 2; }
__host__ __device__ __forceinline__ int perm32(int rho) { const int n = rho >> 4, i = rho & 15; return 8 * (i >> 2) + 4 * n + (i & 3); }

struct Unit { int pm, pn; };
struct Gemm { const bf16_t* A; const bf16_t* Bt; int M, N, K; bool ablk = false, bblk = false; };

struct StaticOrder {
    int nM, nN, nwg, G, c;
    __host__ __device__ void init(int M, int N, int G_, int c_) { nM = M / BM; nN = N / BM; nwg = nM * nN; G = G_; c = c_; }
    __host__ __device__ bool next(int i, Unit& u) const {
        const long L = (long)i * G + c; if (L >= nwg) return false;
        int wgid = (int)L; { const int q = nwg / NXCD, r = nwg % NXCD, xcd = wgid % NXCD, off = wgid / NXCD; wgid = (xcd < r ? xcd * (q + 1) : r * (q + 1) + (xcd - r) * q) + off; }
        const int nig = WGM * nN, gid = wgid / nig, fm = gid * WGM, gsz = (nM - fm) < WGM ? (nM - fm) : WGM;
        u.pm = fm + ((wgid % nig) % gsz); u.pn = (wgid % nig) / gsz; return true;
    }
    __device__ __forceinline__ void a_ready(const Unit&) const {}
    __device__ __forceinline__ void done(const Unit&) const {}
};

__device__ __forceinline__ unsigned cvt_pk_bf16(float lo, float hi) { unsigned r; asm volatile("v_cvt_pk_bf16_f32 %0, %1, %2" : "=v"(r) : "v"(lo), "v"(hi)); return r; }
typedef float f32x2 __attribute__((ext_vector_type(2)));
template <class Epi, class Sched, bool ALIGN_EPI = false, bool SP2 = false>
__device__ __forceinline__ void gemm_phase(PG8_LAS unsigned char* lds, const Gemm g, const Sched& S, const Epi& E) {
    const int tid = threadIdx.x, wid = __builtin_amdgcn_readfirstlane(tid >> 6), lane = tid & 63, wr = wid >> 2, wc = wid & 3, fr = lane & 15, fq = lane >> 4;
    const int K = g.K, nt = K / BK;
    unsigned voffA[2], voffB[2];
#pragma unroll
    for (int i = 0; i < 2; ++i) { int R, C; stage_rc(tid * 16 + i * 8192, R, C); const int Rb = Epi::PERM ? ((R & ~31) + perm32(R & 31)) : R;
        voffA[i] = (unsigned)(R * (g.ablk ? BK : K) + C) * 2u; voffB[i] = (unsigned)(Rb * (g.bblk ? BK : K) + C) * 2u; }
    const size_t kstA = g.ablk ? (size_t)(BM * BK * 2) : (size_t)(BK * 2), kstB = g.bblk ? (size_t)(BM * BK * 2) : (size_t)(BK * 2);
    const size_t hstA = g.ablk ? (size_t)(HALF * BK * 2) : (size_t)HALF * K * 2, hstB = g.bblk ? (size_t)(HALF * BK * 2) : (size_t)HALF * K * 2;
    const size_t tstA = (size_t)BM * K * 2, tstB = (size_t)BM * K * 2;
    const unsigned ldsw = (unsigned)wid * 1024u;
    const int aoff = lds_byte(wr * 64 + fr, fq * 8), boff = lds_byte(wc * 32 + fr, fq * 8);
#define PG8_SA(b, h) (((b) * 2 + (h)) * HTB)
#define PG8_SB(b, h) ((4 + (b) * 2 + (h)) * HTB)
#define PG8_STAGE(bufoff, gbase, voff) do { _Pragma("unroll") for (int _i = 0; _i < 2; ++_i) \
        __builtin_amdgcn_global_load_lds((const unsigned*)((const char*)(gbase) + (voff)[_i]), (PG8_LAS unsigned*)(lds + (bufoff) + ldsw + _i * 8192), 16, 0, 0); } while (0)
#define PG8_LDA(dst, b, h) do { _Pragma("unroll") for (int m = 0; m < 4; ++m) _Pragma("unroll") for (int k = 0; k < 2; ++k) dst[m][k] = *(const PG8_LAS bf16x8*)(lds + PG8_SA(b, h) + aoff + m * 2048 + k * 1024); } while (0)
#define PG8_LDB(dst, b, h) do { _Pragma("unroll") for (int n = 0; n < 2; ++n) _Pragma("unroll") for (int k = 0; k < 2; ++k) dst[n][k] = *(const PG8_LAS bf16x8*)(lds + PG8_SB(b, h) + boff + n * 2048 + k * 1024); } while (0)
#define PG8_MMA(ai, bj, At, Bt) do { __builtin_amdgcn_s_setprio(1); _Pragma("unroll") for (int m = 0; m < 4; ++m) _Pragma("unroll") for (int n = 0; n < 2; ++n) _Pragma("unroll") for (int k = 0; k < 2; ++k) \
        acc[ai][bj][m][n] = __builtin_amdgcn_mfma_f32_16x16x32_bf16(Bt[n][k], At[m][k], acc[ai][bj][m][n], 0, 0, 0); __builtin_amdgcn_s_setprio(0); } while (0)
#define PG8_WAIT_V(n) asm volatile("s_waitcnt vmcnt(" #n ")" ::: "memory")
#define PG8_WAIT_L(n) asm volatile("s_waitcnt lgkmcnt(" #n ")" ::: "memory")
#define PG8_BAR __builtin_amdgcn_s_barrier()
#define PG8_SCHED __builtin_amdgcn_sched_barrier(0)
    Unit cur, nxt; int ui = 0;
    if (!S.next(0, cur)) return;
    f32x4 acc[2][2][4][2];
#pragma unroll
    for (int a = 0; a < 2; ++a)
#pragma unroll
        for (int b = 0; b < 2; ++b)
#pragma unroll
            for (int m = 0; m < 4; ++m)
#pragma unroll
                for (int n = 0; n < 2; ++n) acc[a][b][m][n] = (f32x4){0.f, 0.f, 0.f, 0.f};
    bf16x8 At[4][2], B0[2][2], B1[2][2];
    const char* cA = (const char*)g.A + (size_t)cur.pm * tstA; const char* cB = (const char*)g.Bt + (size_t)cur.pn * tstB;
    S.a_ready(cur);
    if constexpr (SP2) {
        PG8_STAGE(PG8_SB(0, 0), cB, voffB); PG8_STAGE(PG8_SB(0, 1), cB + hstB, voffB); PG8_STAGE(PG8_SA(0, 0), cA, voffA); PG8_STAGE(PG8_SA(0, 1), cA + hstA, voffA);
        if (wr == 1) PG8_BAR;
        PG8_WAIT_V(2); PG8_BAR;
        PG8_STAGE(PG8_SB(1, 0), cB + kstB, voffB); PG8_STAGE(PG8_SA(1, 0), cA + kstA, voffA); PG8_STAGE(PG8_SB(1, 1), cB + hstB + kstB, voffB);
        PG8_WAIT_V(6); PG8_BAR;
    } else {
        PG8_STAGE(PG8_SB(0, 0), cB, voffB); PG8_STAGE(PG8_SA(0, 0), cA, voffA); PG8_STAGE(PG8_SB(0, 1), cB + hstB, voffB); PG8_STAGE(PG8_SA(0, 1), cA + hstA, voffA);
        if (wr == 1) PG8_BAR;
        PG8_WAIT_V(4); PG8_BAR;
        PG8_STAGE(PG8_SB(1, 0), cB + kstB, voffB); PG8_STAGE(PG8_SA(1, 0), cA + kstA, voffA); PG8_STAGE(PG8_SB(1, 1), cB + hstB + kstB, voffB);
        PG8_WAIT_V(6); PG8_BAR;
    }
    for (;;) {
        const bool has_next = S.next(ui + 1, nxt);
        const char* nA = has_next ? (const char*)g.A + (size_t)nxt.pm * tstA : cA; const char* nB = has_next ? (const char*)g.Bt + (size_t)nxt.pn * tstB : cB;
        for (int t = 0; t < nt; t += 2) {
            const bool last = (t == nt - 2);
            const char* a1 = cA + (size_t)(t + 1) * kstA;
            const char* a2 = last ? nA : cA + (size_t)(t + 2) * kstA; const char* b2 = last ? nB : cB + (size_t)(t + 2) * kstB;
            const char* a3 = a2 + kstA; const char* b3 = b2 + kstB;
            if (last && has_next) S.a_ready(nxt);
            if constexpr (SP2) {
            PG8_LDB(B0, 0, 0); PG8_LDB(B1, 0, 1); PG8_SCHED; PG8_LDA(At, 0, 0); PG8_STAGE(PG8_SA(1, 1), a1 + hstA, voffA);
            PG8_WAIT_V(8); PG8_WAIT_L(0); PG8_BAR; PG8_MMA(0, 0, At, B0); PG8_MMA(0, 1, At, B1); PG8_BAR; PG8_SCHED;
            PG8_LDA(At, 0, 1); PG8_STAGE(PG8_SB(0, 0), b2, voffB); PG8_STAGE(PG8_SB(0, 1), b2 + hstB, voffB); PG8_STAGE(PG8_SA(0, 0), a2, voffA);
            PG8_WAIT_V(8); PG8_WAIT_L(0); PG8_BAR; PG8_MMA(1, 0, At, B0); PG8_MMA(1, 1, At, B1); PG8_BAR; PG8_SCHED;
            PG8_LDB(B0, 1, 0); PG8_LDB(B1, 1, 1); PG8_SCHED; PG8_LDA(At, 1, 0); PG8_STAGE(PG8_SA(0, 1), a2 + hstA, voffA);
            PG8_WAIT_V(8); PG8_WAIT_L(0); PG8_BAR; PG8_MMA(0, 0, At, B0); PG8_MMA(0, 1, At, B1); PG8_BAR; PG8_SCHED;
            PG8_LDA(At, 1, 1); PG8_STAGE(PG8_SB(1, 0), b3, voffB); PG8_STAGE(PG8_SB(1, 1), b3 + hstB, voffB); PG8_STAGE(PG8_SA(1, 0), a3, voffA);
            PG8_WAIT_V(8); PG8_WAIT_L(0); PG8_BAR; PG8_MMA(1, 0, At, B0); PG8_MMA(1, 1, At, B1); PG8_BAR; PG8_SCHED;
            } else {
            PG8_LDB(B0, 0, 0); PG8_SCHED; PG8_LDA(At, 0, 0); PG8_STAGE(PG8_SA(1, 1), a1 + hstA, voffA);
            PG8_WAIT_L(8); PG8_BAR; PG8_WAIT_L(0); PG8_MMA(0, 0, At, B0); PG8_BAR; PG8_SCHED;
            PG8_LDB(B1, 0, 1); PG8_STAGE(PG8_SB(0, 0), b2, voffB);
            PG8_BAR; PG8_WAIT_L(0); PG8_MMA(0, 1, At, B1); PG8_BAR;
            PG8_LDA(At, 0, 1); PG8_STAGE(PG8_SA(0, 0), a2, voffA);
            PG8_BAR; PG8_WAIT_L(0); PG8_MMA(1, 0, At, B0); PG8_BAR; PG8_SCHED;
            PG8_STAGE(PG8_SB(0, 1), b2 + hstB, voffB);
            PG8_WAIT_V(6); PG8_BAR; PG8_MMA(1, 1, At, B1); PG8_BAR;
            PG8_LDB(B0, 1, 0); PG8_SCHED; PG8_LDA(At, 1, 0); PG8_STAGE(PG8_SA(0, 1), a2 + hstA, voffA);
            PG8_WAIT_L(8); PG8_BAR; PG8_WAIT_L(0); PG8_MMA(0, 0, At, B0); PG8_BAR; PG8_SCHED;
            PG8_LDB(B1, 1, 1); PG8_STAGE(PG8_SB(1, 0), b3, voffB);
            PG8_BAR; PG8_WAIT_L(0); PG8_MMA(0, 1, At, B1); PG8_BAR;
            PG8_LDA(At, 1, 1); PG8_STAGE(PG8_SA(1, 0), a3, voffA);
            PG8_BAR; PG8_WAIT_L(0); PG8_MMA(1, 0, At, B0); PG8_BAR; PG8_SCHED;
            PG8_STAGE(PG8_SB(1, 1), b3 + hstB, voffB);
            PG8_WAIT_V(6); PG8_BAR; PG8_MMA(1, 1, At, B1); PG8_BAR;
            }
            if constexpr (Epi::MID_T >= 0) { if (t == Epi::MID_T) E.mid(acc, cur, wr, wc, fr, fq); }
        }
        if constexpr (ALIGN_EPI) { if (wr == 0) PG8_BAR; }
        if constexpr (!Epi::AFTER_DRAIN) { E(acc, cur, wr, wc, fr, fq); S.done(cur); }
        if (!has_next) break;
#pragma unroll
        for (int a = 0; a < 2; ++a)
#pragma unroll
            for (int b = 0; b < 2; ++b)
#pragma unroll
                for (int m = 0; m < 4; ++m)
#pragma unroll
                    for (int n = 0; n < 2; ++n) acc[a][b][m][n] = (f32x4){0.f, 0.f, 0.f, 0.f};
        cur = nxt; cA = nA; cB = nB; ++ui;
        if constexpr (ALIGN_EPI) { if (wr == 1) PG8_BAR; }
    }
    PG8_WAIT_V(0);
    if constexpr (!ALIGN_EPI) { if (wr == 0) PG8_BAR; }
    PG8_BAR;
    if constexpr (Epi::AFTER_DRAIN) { E.fused(acc, cur, wr, wc, fr, fq, lds, wid, lane); S.done(cur); }
#undef PG8_SA
#undef PG8_SB
#undef PG8_STAGE
#undef PG8_LDA
#undef PG8_LDB
#undef PG8_MMA
#undef PG8_WAIT_V
#undef PG8_WAIT_L
#undef PG8_BAR
#undef PG8_SCHED
}
}

constexpr int M = 16384, SEQ = 4096, DM = 2048, DFF = 5632, NIN = 10240, HW = 1024, NSS = 32, QP = 2048;
constexpr float EPS = 1e-6f, LOG2E = 1.4426950408889634f;
constexpr float C2 = 0.08838834764831845f * 1.4426950408889634f;

typedef unsigned short bf16;
typedef unsigned u32x4 __attribute__((ext_vector_type(4)));
typedef unsigned u32x2 __attribute__((ext_vector_type(2)));
typedef float f32x4 __attribute__((ext_vector_type(4)));
typedef float f32x16 __attribute__((ext_vector_type(16)));
typedef short bf16x8 __attribute__((ext_vector_type(8)));
typedef short s16x4 __attribute__((ext_vector_type(4)));
#define LAS __attribute__((address_space(3)))
typedef LAS unsigned char* ldsp;

__device__ __forceinline__ float bflo(unsigned w) { return __uint_as_float(w << 16); }
__device__ __forceinline__ float bfhi(unsigned w) { return __uint_as_float(w & 0xffff0000u); }
__device__ __forceinline__ unsigned pk2(float lo, float hi) { return pg8::cvt_pk_bf16(lo, hi); }
__device__ __forceinline__ float fast_sigmoid(float v) { return __builtin_amdgcn_rcpf(1.0f + __builtin_amdgcn_exp2f(-v * LOG2E)); }

namespace pg8 {
__device__ __forceinline__ float row_rstd(const float* ss, int row, int fq) {
    const f32x4* p = (const f32x4*)(ss + (size_t)row * NSS + 8 * fq);
    const f32x4 a = p[0], b = p[1];
    float s = ((a[0] + a[1]) + (a[2] + a[3])) + ((b[0] + b[1]) + (b[2] + b[3]));
    s += __shfl_xor(s, 16); s += __shfl_xor(s, 32);
    return rsqrtf(s * (1.0f / DM) + EPS);
}
__device__ __forceinline__ void rstd8(const float* ss, int row0, int fq, float (&rsv)[8]) {
#pragma unroll
    for (int i = 0; i < 8; ++i) rsv[i] = row_rstd(ss, row0 + (i >> 2) * HALF + (i & 3) * 16, fq);
}
struct EpiSwiglu {
    static constexpr bool PERM = true, AFTER_DRAIN = false; static constexpr int MID_T = -1;
    bf16_t* H; const float* ss; mutable int cpm = -1; mutable float rsv[8] = {};
    __device__ __forceinline__ void operator()(const f32x4 (&acc)[2][2][4][2], const Unit& u, int wr, int wc, int fr, int fq) const {
        const int row0 = u.pm * BM + wr * 64 + fr, col0 = u.pn * 128 + wc * 32 + 8 * fq;
        if (u.pm != cpm) { cpm = u.pm; rstd8(ss, row0, fq, rsv); }
#pragma unroll
        for (int ai = 0; ai < 2; ++ai)
#pragma unroll
            for (int m = 0; m < 4; ++m) {
                const int row = row0 + ai * HALF + m * 16; const float rs = rsv[ai * 4 + m];
                float hv[8];
#pragma unroll
                for (int n = 0; n < 2; ++n)
#pragma unroll
                    for (int e = 0; e < 4; ++e) { const float g = acc[ai][0][m][n][e] * rs, uu = acc[ai][1][m][n][e] * rs; hv[n * 4 + e] = g * fast_sigmoid(g) * uu; }
                u32x4 w; w.x = cvt_pk_bf16(hv[0], hv[1]); w.y = cvt_pk_bf16(hv[2], hv[3]); w.z = cvt_pk_bf16(hv[4], hv[5]); w.w = cvt_pk_bf16(hv[6], hv[7]);
                *(u32x4*)(H + (((size_t)(row >> 8) * (DFF / 64) + (col0 >> 6)) * 256 + (row & 255)) * 64 + (col0 & 63)) = w;
            }
    }
};
template <bool RESBF> struct EpiResid {
    static constexpr bool PERM = true, AFTER_DRAIN = false; static constexpr int MID_T = -1;
    const void* res; float* out; bf16_t* xb; float* ss; float alpha;
    __device__ __forceinline__ void operator()(const f32x4 (&acc)[2][2][4][2], const Unit& u, int wr, int wc, int fr, int fq) const {
        const int row0 = u.pm * BM + wr * 64 + fr, col0 = u.pn * BM + wc * 32 + 8 * fq;
        u32x4 pre[2][4][2];
        if (RESBF) {
#pragma unroll
            for (int ai = 0; ai < 2; ++ai)
#pragma unroll
                for (int m = 0; m < 4; ++m)
#pragma unroll
                    for (int bj = 0; bj < 2; ++bj) pre[ai][m][bj] = *(const u32x4*)((const bf16_t*)res + (size_t)(row0 + ai * HALF + m * 16) * DM + col0 + bj * HALF);
        }
#pragma unroll
        for (int ai = 0; ai < 2; ++ai)
#pragma unroll
            for (int m = 0; m < 4; ++m) {
                const int row = row0 + ai * HALF + m * 16; const size_t off = (size_t)row * DM + col0; float s = 0.f;
#pragma unroll
                for (int bj = 0; bj < 2; ++bj) {
                    f32x4 r0, r1;
                    if (RESBF) { const u32x4 p = pre[ai][m][bj]; r0 = (f32x4){bflo(p.x), bfhi(p.x), bflo(p.y), bfhi(p.y)}; r1 = (f32x4){bflo(p.z), bfhi(p.z), bflo(p.w), bfhi(p.w)}; }
                    else { r0 = *(const f32x4*)((const float*)res + off + bj * HALF); r1 = *(const f32x4*)((const float*)res + off + bj * HALF + 4); }
                    const f32x4 v0 = r0 + acc[ai][bj][m][0] * alpha, v1 = r1 + acc[ai][bj][m][1] * alpha;
                    if (out) { *(f32x4*)(out + off + bj * HALF) = v0; *(f32x4*)(out + off + bj * HALF + 4) = v1; }
                    s += ((v0[0] * v0[0] + v0[1] * v0[1]) + (v0[2] * v0[2] + v0[3] * v0[3])) + ((v1[0] * v1[0] + v1[1] * v1[1]) + (v1[2] * v1[2] + v1[3] * v1[3]));
                    if (xb) { u32x4 w; w.x = cvt_pk_bf16(v0[0], v0[1]); w.y = cvt_pk_bf16(v0[2], v0[3]); w.z = cvt_pk_bf16(v1[0], v1[1]); w.w = cvt_pk_bf16(v1[2], v1[3]); *(u32x4*)(xb + off + bj * HALF) = w; }
                }
                s += __shfl_xor(s, 16); s += __shfl_xor(s, 32);
                if (fq == 0) ss[(size_t)row * NSS + u.pn * 4 + wc] = s;
            }
    }
};
struct EpiIn {
    static constexpr bool PERM = true, AFTER_DRAIN = false; static constexpr int MID_T = -1;
    bf16_t *qsb, *ksb, *vsb, *qca, *kca, *vca, *gates; float* qkss; const float* ss; const float* bgate;
    __device__ __forceinline__ void operator()(const f32x4 (&acc)[2][2][4][2], const Unit& u, int wr, int wc, int fr, int fq) const {
        const int row0 = u.pm * BM + wr * 64 + fr; const int pn = u.pn;
        if (pn < 24) {
            const int t = pn >> 2; bf16_t* dst = t == 0 ? qsb : t == 1 ? ksb : t == 2 ? vsb : t == 3 ? qca : t == 4 ? kca : vca;
            const float sc = (t == 0) ? C2 : 1.0f; const bool stat = (t == 3 || t == 4);
            const int col0 = (pn & 3) * BM + wc * 32 + 8 * fq;
#pragma unroll
            for (int ai = 0; ai < 2; ++ai)
#pragma unroll
                for (int m = 0; m < 4; ++m) {
                    const int row = row0 + ai * HALF + m * 16; const float rs = row_rstd(ss, row, fq) * sc;
#pragma unroll
                    for (int bj = 0; bj < 2; ++bj) {
                        const f32x4 v0 = acc[ai][bj][m][0] * rs, v1 = acc[ai][bj][m][1] * rs;
                        u32x4 w; w.x = cvt_pk_bf16(v0[0], v0[1]); w.y = cvt_pk_bf16(v0[2], v0[3]); w.z = cvt_pk_bf16(v1[0], v1[1]); w.w = cvt_pk_bf16(v1[2], v1[3]);
                        *(u32x4*)(dst + (size_t)row * ((t == 0 || t == 3) ? QP : HW) + col0 + bj * HALF) = w;
                        if (stat) {
                            float s = ((v0[0] * v0[0] + v0[1] * v0[1]) + (v0[2] * v0[2] + v0[3] * v0[3])) + ((v1[0] * v1[0] + v1[1] * v1[1]) + (v1[2] * v1[2] + v1[3] * v1[3]));
                            s += __shfl_xor(s, 16); s += __shfl_xor(s, 32);
                            if (fq == 0) qkss[(size_t)row * 64 + ((t - 3) * 8 + (pn & 3) * 2 + bj) * 4 + wc] = s;
                        }
                    }
                }
        } else {
            const int col0 = (pn - 24) * BM + wc * 32 + 8 * fq;
            f32x4 bv[2][2];
#pragma unroll
            for (int bj = 0; bj < 2; ++bj)
#pragma unroll
                for (int n = 0; n < 2; ++n) bv[bj][n] = *(const f32x4*)(bgate + col0 + bj * HALF + 4 * n);
#pragma unroll
            for (int ai = 0; ai < 2; ++ai)
#pragma unroll
                for (int m = 0; m < 4; ++m) {
                    const int row = row0 + ai * HALF + m * 16; const float rs = row_rstd(ss, row, fq);
#pragma unroll
                    for (int bj = 0; bj < 2; ++bj) {
                        const f32x4 v0 = acc[ai][bj][m][0] * rs + bv[bj][0], v1 = acc[ai][bj][m][1] * rs + bv[bj][1];
                        u32x4 w; w.x = cvt_pk_bf16(fast_sigmoid(v0[0]), fast_sigmoid(v0[1])); w.y = cvt_pk_bf16(fast_sigmoid(v0[2]), fast_sigmoid(v0[3]));
                        w.z = cvt_pk_bf16(fast_sigmoid(v1[0]), fast_sigmoid(v1[1])); w.w = cvt_pk_bf16(fast_sigmoid(v1[2]), fast_sigmoid(v1[3]));
                        *(u32x4*)(gates + (size_t)row * (2 * DM) + col0 + bj * HALF) = w;
                    }
                }
        }
    }
};
struct EpiGateF {
    static constexpr bool PERM = true, AFTER_DRAIN = false; static constexpr int MID_T = 14;
    const bf16_t* gates; bf16_t* G;
    __device__ __forceinline__ void mid(f32x4 (&acc)[2][2][4][2], const Unit& u, int wr, int wc, int fr, int fq) const {
        asm volatile("" : "+v"(fr), "+v"(fq));
        const int row0 = u.pm * BM + wr * 64 + fr, col0 = u.pn * BM + wc * 32 + 8 * fq;
#pragma unroll
        for (int ai = 0; ai < 2; ++ai)
#pragma unroll
            for (int m = 0; m < 4; ++m) {
                const int row = row0 + ai * HALF + m * 16;
#pragma unroll
                for (int bj = 0; bj < 2; ++bj) {
                    const bf16_t* gp = gates + (size_t)row * (2 * DM) + col0 + bj * HALF;
                    const u32x4 ga = *(const u32x4*)gp, gb = *(const u32x4*)(gp + DM);
                    const float ra[8] = {bflo(ga.x), bfhi(ga.x), bflo(ga.y), bfhi(ga.y), bflo(ga.z), bfhi(ga.z), bflo(ga.w), bfhi(ga.w)};
                    const float rb[8] = {bflo(gb.x), bfhi(gb.x), bflo(gb.y), bfhi(gb.y), bflo(gb.z), bfhi(gb.z), bflo(gb.w), bfhi(gb.w)};
#pragma unroll
                    for (int e = 0; e < 4; ++e) { acc[ai][bj][m][0][e] *= ra[e] * __builtin_amdgcn_rcpf(__builtin_fmaxf(rb[e], 1e-30f)); acc[ai][bj][m][1][e] *= ra[4 + e] * __builtin_amdgcn_rcpf(__builtin_fmaxf(rb[4 + e], 1e-30f)); }
                }
                if (m & 1) asm volatile("" ::: "memory");
            }
    }
    __device__ __forceinline__ void operator()(const f32x4 (&acc)[2][2][4][2], const Unit& u, int wr, int wc, int fr, int fq) const {
        const int row0 = u.pm * BM + wr * 64 + fr, col0 = u.pn * BM + wc * 32 + 8 * fq;
        u32x4 pre[2][4][2];
#pragma unroll
        for (int ai = 0; ai < 2; ++ai)
#pragma unroll
            for (int m = 0; m < 4; ++m)
#pragma unroll
                for (int bj = 0; bj < 2; ++bj) pre[ai][m][bj] = *(const u32x4*)(gates + (size_t)(row0 + ai * HALF + m * 16) * (2 * DM) + DM + col0 + bj * HALF);
#pragma unroll
        for (int ai = 0; ai < 2; ++ai)
#pragma unroll
            for (int m = 0; m < 4; ++m) {
                const int row = row0 + ai * HALF + m * 16;
#pragma unroll
                for (int bj = 0; bj < 2; ++bj) {
                    const u32x4 gb = pre[ai][m][bj];
                    const f32x4 a0 = acc[ai][bj][m][0], a1 = acc[ai][bj][m][1];
                    const float v[8] = {__builtin_fmaxf(bflo(gb.x), 1e-30f) * a0[0], __builtin_fmaxf(bfhi(gb.x), 1e-30f) * a0[1], __builtin_fmaxf(bflo(gb.y), 1e-30f) * a0[2], __builtin_fmaxf(bfhi(gb.y), 1e-30f) * a0[3],
                                        __builtin_fmaxf(bflo(gb.z), 1e-30f) * a1[0], __builtin_fmaxf(bfhi(gb.z), 1e-30f) * a1[1], __builtin_fmaxf(bflo(gb.w), 1e-30f) * a1[2], __builtin_fmaxf(bfhi(gb.w), 1e-30f) * a1[3]};
                    u32x4 w; w.x = cvt_pk_bf16(v[0], v[1]); w.y = cvt_pk_bf16(v[2], v[3]); w.z = cvt_pk_bf16(v[4], v[5]); w.w = cvt_pk_bf16(v[6], v[7]);
                    *(u32x4*)(G + (size_t)row * DM + col0 + bj * HALF) = w;
                }
            }
    }
};
struct PanelOrder {
    int c;
    __host__ __device__ void init(int c_) { c = c_; }
    __host__ __device__ bool next(int i, Unit& u) const { if (i >= 2) return false; const int xcd = c & 7, idx = c >> 3; u.pm = 32 * i + 4 * xcd + (idx >> 3); u.pn = idx & 7; return true; }
    __device__ __forceinline__ void a_ready(const Unit&) const {}
    __device__ __forceinline__ void done(const Unit&) const {}
};
struct EpiFinal {
    static constexpr bool PERM = true, AFTER_DRAIN = false; static constexpr int MID_T = -1;
    const bf16_t* res; float* out; const float* gain; float* xs; unsigned* cnt; PG8_LAS unsigned char* ldsx; float alpha;
    __device__ __forceinline__ void operator()(f32x4 (&acc)[2][2][4][2], const Unit& u, int wr, int wc, int fr, int fq) const {
        const int tid = threadIdx.x, lane = tid & 63, wid = __builtin_amdgcn_readfirstlane(tid >> 6);
        PG8_LAS float* P = (PG8_LAS float*)ldsx;
        PG8_LAS float* S = (PG8_LAS float*)(ldsx + 4096);
        const int rl0 = wr * 64 + fr, col0 = u.pn * BM + wc * 32 + 8 * fq;
        u32x4 pre[2][4][2];
#pragma unroll
        for (int ai = 0; ai < 2; ++ai)
#pragma unroll
            for (int m = 0; m < 4; ++m)
#pragma unroll
                for (int bj = 0; bj < 2; ++bj) pre[ai][m][bj] = *(const u32x4*)(res + (size_t)(u.pm * BM + rl0 + ai * HALF + m * 16) * DM + col0 + bj * HALF);
#pragma unroll
        for (int ai = 0; ai < 2; ++ai)
#pragma unroll
            for (int m = 0; m < 4; ++m) {
                const int rl = rl0 + ai * HALF + m * 16; const size_t off = (size_t)(u.pm * BM + rl) * DM + col0; float s = 0.f;
#pragma unroll
                for (int bj = 0; bj < 2; ++bj) {
                    const u32x4 p = pre[ai][m][bj];
                    const f32x4 v0 = (f32x4){bflo(p.x), bfhi(p.x), bflo(p.y), bfhi(p.y)} + acc[ai][bj][m][0] * alpha, v1 = (f32x4){bflo(p.z), bfhi(p.z), bflo(p.w), bfhi(p.w)} + acc[ai][bj][m][1] * alpha;
                    acc[ai][bj][m][0] = v0; acc[ai][bj][m][1] = v1;
                    s += ((v0[0] * v0[0] + v0[1] * v0[1]) + (v0[2] * v0[2] + v0[3] * v0[3])) + ((v1[0] * v1[0] + v1[1] * v1[1]) + (v1[2] * v1[2] + v1[3] * v1[3]));
                }
                s += __shfl_xor(s, 16); s += __shfl_xor(s, 32);
                if (fq == 0) P[rl * 4 + wc] = s;
            }
        asm volatile("s_waitcnt lgkmcnt(0)" ::: "memory"); __builtin_amdgcn_s_barrier(); asm volatile("" ::: "memory");
        if (tid < 256) {
            const f32x4 t = *(const PG8_LAS f32x4*)(P + tid * 4);
            __hip_atomic_store(xs + ((size_t)(u.pm * BM + tid) * 8 + u.pn), (t[0] + t[1]) + (t[2] + t[3]), __ATOMIC_RELAXED, __HIP_MEMORY_SCOPE_AGENT);
        }
        asm volatile("s_waitcnt vmcnt(0)" ::: "memory");
        if (tid < 256 && lane == 0) __hip_atomic_fetch_add(cnt + 64 * u.pm, 1u, __ATOMIC_RELAXED, __HIP_MEMORY_SCOPE_AGENT);
        if (wid == 0) {
            unsigned spins = 0;
            while ((unsigned)__builtin_amdgcn_readfirstlane((int)__hip_atomic_load(cnt + 64 * u.pm, __ATOMIC_RELAXED, __HIP_MEMORY_SCOPE_AGENT)) < 32u) { __builtin_amdgcn_s_sleep(2); if (++spins > (1u << 22)) break; }
            __builtin_amdgcn_fence(__ATOMIC_ACQUIRE, "agent");
        }
        asm volatile("s_waitcnt vmcnt(0) lgkmcnt(0)" ::: "memory"); __builtin_amdgcn_s_barrier(); asm volatile("" ::: "memory");
        if (tid < 256) {
            const float* sl = xs + (size_t)(u.pm * BM + tid) * 8; float q = 0.f;
#pragma unroll
            for (int t = 0; t < 8; ++t) q += __hip_atomic_load(sl + t, __ATOMIC_RELAXED, __HIP_MEMORY_SCOPE_AGENT);
            S[tid] = rsqrtf(q * (1.0f / DM) + EPS);
        }
        asm volatile("s_waitcnt lgkmcnt(0)" ::: "memory"); __builtin_amdgcn_s_barrier(); asm volatile("" ::: "memory");
        f32x4 gv[2][2];
#pragma unroll
        for (int bj = 0; bj < 2; ++bj)
#pragma unroll
            for (int n = 0; n < 2; ++n) gv[bj][n] = *(const f32x4*)(gain + col0 + bj * HALF + 4 * n);
#pragma unroll
        for (int ai = 0; ai < 2; ++ai)
#pragma unroll
            for (int m = 0; m < 4; ++m) {
                const int rl = rl0 + ai * HALF + m * 16; const size_t off = (size_t)(u.pm * BM + rl) * DM + col0; const float rs = S[rl];
#pragma unroll
                for (int bj = 0; bj < 2; ++bj) { *(f32x4*)(out + off + bj * HALF) = acc[ai][bj][m][0] * rs * gv[bj][0]; *(f32x4*)(out + off + bj * HALF + 4) = acc[ai][bj][m][1] * rs * gv[bj][1]; }
            }
    }
};
}

namespace att {
constexpr int KB0 = 0, VB0 = 32768, TILEB = 16384, WSC = 65536, RELB = 67584, GQK = 68608, KSC = 69632, DONE = 70656;
__device__ __forceinline__ unsigned off_b(unsigned row, unsigned ch) { return 256u * row + 16u * (ch ^ (((row & 3) << 2) | ((row >> 2) & 3))); }
struct Addr { unsigned kb[8]; unsigned vb[2][4]; };
__device__ __forceinline__ void addr_init(Addr& a, int lane) {
    const unsigned r32 = lane & 31, hi = lane >> 5, xr = ((r32 & 3) << 2) | ((r32 >> 2) & 3);
#pragma unroll
    for (int s = 0; s < 8; ++s) a.kb[s] = 256u * r32 + 16u * ((2u * s + hi) ^ xr);
    const unsigned blk = (lane >> 4) & 1, q = (lane & 15) >> 2, p = lane & 3, cl = 2 * blk + (p >> 1), R0 = 4 * hi + q;
#pragma unroll
    for (int t = 0; t < 2; ++t)
#pragma unroll
        for (int c = 0; c < 4; ++c) a.vb[t][c] = 256u * R0 + 64u * ((unsigned)c ^ q) + 16u * (cl ^ (2u * t + hi)) + 8u * (p & 1);
}
template <int SUB> __device__ __forceinline__ f32x16 qk_sub(ldsp Kb, const Addr& a, const bf16x8 (&qr)[8]) {
    f32x16 p = {};
#pragma unroll
    for (int s = 0; s < 8; ++s) { const bf16x8 kf = *(const LAS bf16x8*)(Kb + a.kb[s] + 8192 * SUB); p = __builtin_amdgcn_mfma_f32_32x32x16_bf16(kf, qr[s], p, 0, 0, 0); }
    return p;
}
__device__ __forceinline__ s16x4 vtr(ldsp p) { return __builtin_bit_cast(s16x4, __builtin_amdgcn_ds_read_tr16_b64_v4i16((LAS s16x4*)p)); }
template <int SUB> __device__ __forceinline__ void pv_sub(f32x16 (&o)[4], ldsp Vb, const Addr& a, const f32x16& p) {
    u32x4 w0, w1;
    w0.x = pk2(p[0], p[1]); w0.y = pk2(p[2], p[3]); w0.z = pk2(p[4], p[5]); w0.w = pk2(p[6], p[7]);
    w1.x = pk2(p[8], p[9]); w1.y = pk2(p[10], p[11]); w1.z = pk2(p[12], p[13]); w1.w = pk2(p[14], p[15]);
    const bf16x8 pa0 = __builtin_bit_cast(bf16x8, w0), pa1 = __builtin_bit_cast(bf16x8, w1);
#pragma unroll
    for (int c = 0; c < 4; ++c)
#pragma unroll
        for (int ks = 0; ks < 2; ++ks) {
            const s16x4 lo = vtr(Vb + a.vb[0][c] + 256 * (32 * SUB + 16 * ks)), hi4 = vtr(Vb + a.vb[1][c] + 256 * (32 * SUB + 16 * ks + 8));
            const bf16x8 vf = {lo[0], lo[1], lo[2], lo[3], hi4[0], hi4[1], hi4[2], hi4[3]};
            o[c] = __builtin_amdgcn_mfma_f32_32x32x16_bf16(ks ? pa1 : pa0, vf, o[c], 0, 0, 0);
        }
}
template <bool MASK> __device__ __forceinline__ void sb_sub(f32x16& p, float& carry, int srel, int hi) {
    float L[16];
#pragma unroll
    for (int r = 0; r < 16; ++r) {
        const float z = p[r];
        const float lg = __builtin_amdgcn_logf(1.0f + __builtin_amdgcn_exp2f(-__builtin_fabsf(z)));
        float l = -(__builtin_fmaxf(z, 0.f) + lg);
        if (MASK && (srel + (r & 3) + 8 * (r >> 2) >= 0)) l = 0.f;
        L[r] = l;
    }
    float gs[4], go[4], suf[4];
#pragma unroll
    for (int g = 0; g < 4; ++g) { gs[g] = (L[4 * g] + L[4 * g + 1]) + (L[4 * g + 2] + L[4 * g + 3]); go[g] = __shfl_xor(gs[g], 32); }
    suf[3] = carry; suf[2] = suf[3] + (gs[3] + go[3]); suf[1] = suf[2] + (gs[2] + go[2]); suf[0] = suf[1] + (gs[1] + go[1]); carry = suf[0] + (gs[0] + go[0]);
#pragma unroll
    for (int g = 0; g < 4; ++g) {
        float incl = suf[g] + (hi ? 0.f : go[g]);
#pragma unroll
        for (int e = 3; e >= 0; --e) {
            const int r = 4 * g + e; incl += L[r];
            float w = __builtin_amdgcn_exp2f(p[r] + incl);
            if (MASK && (srel + (r & 3) + 8 * (r >> 2) >= 0)) w = 0.f;
            p[r] = w;
        }
    }
}
__device__ __forceinline__ void store_o(const f32x16 (&o)[4], ldsp stg, bf16* Og  , int lane) {
    asm volatile("" : "+v"(lane));
    const int r32 = lane & 31, hi = lane >> 5;
#pragma unroll
    for (int c = 0; c < 4; ++c)
#pragma unroll
        for (int r = 0; r < 16; ++r) { const int row = (r & 3) + 8 * (r >> 2) + 4 * hi; *(LAS bf16*)(stg + row * 256 + (32 * c + r32) * 2) = (bf16)(pk2(o[c][r], 0.f) & 0xffffu); }
    asm volatile("s_waitcnt lgkmcnt(0)" ::: "memory");
#pragma unroll
    for (int i = 0; i < 8; ++i) { const int row = 4 * i + (lane >> 4), ch = lane & 15; const u32x4 v = *(const LAS u32x4*)(stg + row * 256 + ch * 16); *(u32x4*)(Og + (size_t)row * QP + ch * 8) = v; }
}

__device__ __forceinline__ void sb_unit(int b, int h, int qb, const bf16* Q, const bf16* K, const bf16* V, bf16* O, ldsp lds, const Addr& ad) {
    const int tid = threadIdx.x, lane = tid & 63, r32 = lane & 31, hi = lane >> 5, wid = __builtin_amdgcn_readfirstlane(tid >> 6);
    const int q0 = qb * 256, wmin = q0 + 32 * wid, tq = wmin + r32;
    const size_t rowbase = (size_t)b * SEQ;
    bf16x8 qr[8];
    { const bf16* qp = Q + (rowbase + tq) * QP + h * 128 + hi * 8;
#pragma unroll
      for (int s = 0; s < 8; ++s) qr[s] = *(const bf16x8*)(qp + 16 * s); }
    f32x16 o[4];
#pragma unroll
    for (int c = 0; c < 4; ++c) o[c] = (f32x16){};
    float carry = 0.f;
    const int NT = (q0 + 256) / 64;
    const bf16* Kh = K + rowbase * HW + h * 128; const bf16* Vh = V + rowbase * HW + h * 128;
    unsigned dgo[2];
#pragma unroll
    for (int i = 0; i < 2; ++i) { const unsigned piece = 2 * wid + i, row = 4 * piece + (lane >> 4), xr = (((unsigned)lane >> 4) << 2) | (piece & 3); dgo[i] = row * HW + (((unsigned)lane & 15) ^ xr) * 8; }
#define SB_DMA(kt, buf) do { const bf16* kp_ = Kh + (size_t)(kt) * 64 * HW; const bf16* vp_ = Vh + (size_t)(kt) * 64 * HW; \
        _Pragma("unroll") for (int i_ = 0; i_ < 2; ++i_) { \
            __builtin_amdgcn_global_load_lds((const unsigned*)(kp_ + dgo[i_]), (LAS unsigned*)(lds + KB0 + (buf) * TILEB + (2 * wid + i_) * 1024), 16, 0, 0); \
            __builtin_amdgcn_global_load_lds((const unsigned*)(vp_ + dgo[i_]), (LAS unsigned*)(lds + VB0 + (buf) * TILEB + (2 * wid + i_) * 1024), 16, 0, 0); } } while (0)
    LAS int* doneAt = (LAS int*)(lds + DONE);
    if (tid < 8) doneAt[tid] = 0x7fffffff;
    bool wdone = false;
    SB_DMA(NT - 1, 0); __syncthreads();
    for (int it = 0; it < NT; ++it) {
        const int kt = NT - 1 - it, cur = it & 1;
        if (it + 1 < NT) SB_DMA(kt - 1, cur ^ 1);
        const int k0 = 64 * kt;
        if (!wdone && k0 < wmin + 31) {
            ldsp Kb = lds + KB0 + cur * TILEB, Vb = lds + VB0 + cur * TILEB;
            if (k0 + 32 < wmin + 31) {
                f32x16 p = qk_sub<1>(Kb, ad, qr);
                const int srel = k0 + 32 + 4 * hi - tq;
                if (k0 + 63 >= wmin) sb_sub<true>(p, carry, srel, hi); else sb_sub<false>(p, carry, srel, hi);
                pv_sub<1>(o, Vb, ad, p);
            }
            {
                f32x16 p = qk_sub<0>(Kb, ad, qr);
                const int srel = k0 + 4 * hi - tq;
                if (k0 + 31 >= wmin) sb_sub<true>(p, carry, srel, hi); else sb_sub<false>(p, carry, srel, hi);
                pv_sub<0>(o, Vb, ad, p);
            }
            if (__all(carry < -150.0f)) { wdone = true; if (lane == 0) doneAt[wid] = it; }
        }
        __syncthreads();
        { const LAS u32x4* dp = (const LAS u32x4*)doneAt; const u32x4 d0 = dp[0], d1 = dp[1];
          int mxd = (int)d0.x; mxd = max(mxd, (int)d0.y); mxd = max(mxd, (int)d0.z); mxd = max(mxd, (int)d0.w); mxd = max(mxd, (int)d1.x); mxd = max(mxd, (int)d1.y); mxd = max(mxd, (int)d1.z); mxd = max(mxd, (int)d1.w);
          if (__builtin_amdgcn_readfirstlane(mxd) <= it) break; }
    }
#undef SB_DMA
    store_o(o, lds + wid * 8192, O + (rowbase + wmin) * QP + h * 128, lane);
    __syncthreads();
}

__device__ __forceinline__ void ca_unit(int b, int h, int cb, const bf16* Q, const bf16* K, const bf16* V, bf16* O, const float* qkss,
                                        const float* gq, const float* gk, const float* relbias, ldsp lds, const Addr& ad) {
    const int tid = threadIdx.x, lane = tid & 63, r32 = lane & 31, hi = lane >> 5, wid = __builtin_amdgcn_readfirstlane(tid >> 6);
    const int c0 = cb * 4, cw = c0 + (wid >> 1), irow = 32 * (wid & 1) + r32, tq = 64 * cw + irow;
    const size_t rowbase = (size_t)b * SEQ;
    LAS float* relb = (LAS float*)(lds + RELB); LAS float* gqk = (LAS float*)(lds + GQK); LAS float* ksc = (LAS float*)(lds + KSC);
    LAS float* wsf = (LAS float*)(lds + WSC) + wid * 64;
    { int t2 = tid; asm volatile("" : "+v"(t2));
      if (t2 < 192) relb[t2] = relbias[h * 192 + t2] * LOG2E;
      if (t2 >= 256 && t2 < 384) { const int d = t2 - 256; gqk[d] = gq[d] * gk[d] * C2; } }
    __syncthreads();
    bf16x8 qr[8];
    { const f32x4 pq = *(const f32x4*)(qkss + (rowbase + tq) * 64 + h * 4);
      const float rq = rsqrtf(((pq[0] + pq[1]) + (pq[2] + pq[3])) * (1.0f / 128.0f) + EPS);
      const bf16* qp = Q + (rowbase + tq) * QP + h * 128 + hi * 8;
#pragma unroll
      for (int s = 0; s < 8; ++s) {
          const u32x4 raw = *(const u32x4*)(qp + 16 * s); const LAS float* g = gqk + 16 * s + 8 * hi;
          u32x4 w; w.x = pk2(bflo(raw.x) * rq * g[0], bfhi(raw.x) * rq * g[1]); w.y = pk2(bflo(raw.y) * rq * g[2], bfhi(raw.y) * rq * g[3]);
          w.z = pk2(bflo(raw.z) * rq * g[4], bfhi(raw.z) * rq * g[5]); w.w = pk2(bflo(raw.w) * rq * g[6], bfhi(raw.w) * rq * g[7]);
          qr[s] = __builtin_bit_cast(bf16x8, w);
      } }
    f32x16 o[4];
#pragma unroll
    for (int c = 0; c < 4; ++c) o[c] = (f32x16){};
    float mrun = -1e30f, lrun = 0.f;
    const int kc0 = (c0 - 8 > 0) ? c0 - 8 : 0, NT = c0 + 4 - kc0;
    const bf16* Kh = K + rowbase * HW + h * 128; const bf16* Vh = V + rowbase * HW + h * 128;
    unsigned dgo[2];
#pragma unroll
    for (int i = 0; i < 2; ++i) { const unsigned piece = 2 * wid + i, row = 4 * piece + (lane >> 4), xr = (((unsigned)lane >> 4) << 2) | (piece & 3); dgo[i] = row * HW + (((unsigned)lane & 15) ^ xr) * 8; }
    f32x4 kpr = {1.f, 1.f, 1.f, 1.f};
#define CA_DMA(kc, buf) do { const bf16* kp_ = Kh + (size_t)(kc) * 64 * HW; const bf16* vp_ = Vh + (size_t)(kc) * 64 * HW; \
        _Pragma("unroll") for (int i_ = 0; i_ < 2; ++i_) { \
            __builtin_amdgcn_global_load_lds((const unsigned*)(kp_ + dgo[i_]), (LAS unsigned*)(lds + KB0 + (buf) * TILEB + (2 * wid + i_) * 1024), 16, 0, 0); \
            __builtin_amdgcn_global_load_lds((const unsigned*)(vp_ + dgo[i_]), (LAS unsigned*)(lds + VB0 + (buf) * TILEB + (2 * wid + i_) * 1024), 16, 0, 0); } \
        if (tid < 64) kpr = *(const f32x4*)(qkss + (rowbase + (size_t)(kc) * 64 + tid) * 64 + (8 + h) * 4); } while (0)
#define CA_KSC(buf) do { if (tid < 64) ksc[(buf) * 64 + tid] = rsqrtf(((kpr[0] + kpr[1]) + (kpr[2] + kpr[3])) * (1.0f / 128.0f) + EPS); } while (0)
    CA_DMA(kc0, 0); CA_KSC(0); __syncthreads();
    for (int it = 0; it < NT; ++it) {
        const int kc = kc0 + it, cur = it & 1;
        if (it + 1 < NT) CA_DMA(kc + 1, cur ^ 1);
        const int jc = kc - (cw - 8);
        if (jc >= 0 && jc <= 8) {
            ldsp Kb = lds + KB0 + cur * TILEB, Vb = lds + VB0 + cur * TILEB;
            const LAS float* kscb = ksc + cur * 64 + 4 * hi;
            const int dbase = irow + 64 * (8 - jc) - 4 * hi;
#define CA_SUB(SUB) do { \
            f32x16 p = qk_sub<SUB>(Kb, ad, qr); \
            if (jc <= 5) { const float bc = relb[191]; \
                _Pragma("unroll") for (int g = 0; g < 4; ++g) { const f32x4 s0 = *(const LAS f32x4*)(kscb + 32 * SUB + 8 * g); \
                    _Pragma("unroll") for (int e = 0; e < 4; ++e) p[4 * g + e] = p[4 * g + e] * s0[e] + bc; } \
            } else { \
                _Pragma("unroll") for (int g = 0; g < 4; ++g) { const f32x4 s0 = *(const LAS f32x4*)(kscb + 32 * SUB + 8 * g); \
                    _Pragma("unroll") for (int e = 0; e < 4; ++e) { const int d0 = dbase - (32 * SUB + 8 * g + e); p[4 * g + e] = p[4 * g + e] * s0[e] + relb[(d0 < 128 ? d0 : 128) + 63]; } } \
            } \
            float mx = p[0]; \
            _Pragma("unroll") for (int r = 1; r < 16; ++r) mx = __builtin_fmaxf(mx, p[r]); \
            mx = __builtin_fmaxf(mx, __shfl_xor(mx, 32)); \
            const float mnew = __builtin_fmaxf(mrun, mx); \
            if (__any(mnew > mrun)) { \
                const float alpha = __builtin_amdgcn_exp2f(mrun - mnew); lrun *= alpha; mrun = mnew; \
                if (hi == 0) wsf[r32] = alpha; \
                asm volatile("s_waitcnt lgkmcnt(0)" ::: "memory"); \
                _Pragma("unroll") for (int g = 0; g < 4; ++g) { const f32x4 al = *(const LAS f32x4*)(wsf + 8 * g + 4 * hi); \
                    _Pragma("unroll") for (int c = 0; c < 4; ++c) _Pragma("unroll") for (int e = 0; e < 4; ++e) o[c][4 * g + e] *= al[e]; } \
            } \
            float ps = 0.f; \
            _Pragma("unroll") for (int r = 0; r < 16; ++r) { p[r] = __builtin_amdgcn_exp2f(p[r] - mrun); ps += p[r]; } \
            lrun += ps; \
            pv_sub<SUB>(o, Vb, ad, p); } while (0)
            CA_SUB(0); CA_SUB(1);
#undef CA_SUB
        }
        if (it + 1 < NT) CA_KSC(cur ^ 1);
        __syncthreads();
    }
#undef CA_DMA
#undef CA_KSC
    { const float lt = lrun + __shfl_xor(lrun, 32);
      if (hi == 0) wsf[r32] = __builtin_amdgcn_rcpf(lt);
      asm volatile("s_waitcnt lgkmcnt(0)" ::: "memory");
#pragma unroll
      for (int g = 0; g < 4; ++g) { const f32x4 al = *(const LAS f32x4*)(wsf + 8 * g + 4 * hi);
#pragma unroll
          for (int c = 0; c < 4; ++c)
#pragma unroll
              for (int e = 0; e < 4; ++e) o[c][4 * g + e] *= al[e]; } }
    store_o(o, lds + wid * 8192, O + (rowbase + 64 * cw + 32 * (wid & 1)) * QP + h * 128, lane);
    __syncthreads();
}
}

#define RLX_AGENT __ATOMIC_RELAXED, __HIP_MEMORY_SCOPE_AGENT
#define XB_TMO      128
#define XB_XCNT(j)  (256  + 64 * (j))
#define XB_XSUB(j)  (1280 + 64 * (j))
#define XB_XGEN(j)  (2304 + 64 * (j))
#define XB_TOP      3328
#define XB_TOPGEN   3392
#define XCD_BAR_WORDS 3456
#define XB_SPIN_CAP (1u << 18)

__device__ __forceinline__ unsigned xb_ld(unsigned* p)              { return __hip_atomic_load(p, __ATOMIC_RELAXED, __HIP_MEMORY_SCOPE_AGENT); }
__device__ __forceinline__ unsigned xb_add(unsigned* p, unsigned v) { return __hip_atomic_fetch_add(p, v, __ATOMIC_RELAXED, __HIP_MEMORY_SCOPE_AGENT); }
__device__ __forceinline__ unsigned xb_xcc_id() { return (unsigned)__builtin_amdgcn_s_getreg((3 << 11) | 20) & 0xFu; }
#define XB_SPIN(cond, bar) do { unsigned _sp = 0; while (cond) { __builtin_amdgcn_s_sleep(1); \
    if ((++_sp & 255u) == 0u) { if (xb_ld(&(bar)[XB_TMO])) break; if (_sp > XB_SPIN_CAP) { atomicAdd(&(bar)[XB_TMO], 1u); break; } } } } while (0)

struct XcdBarrier {
    unsigned* bar; unsigned x;
    volatile LAS unsigned* st;
};

__device__ __forceinline__ XcdBarrier xcd_barrier_post(unsigned* bar, volatile LAS unsigned* st) {
    XcdBarrier b; b.bar = bar; b.x = xb_xcc_id(); b.st = st;
    if (threadIdx.x == 0) (void)xb_add(&bar[XB_XCNT(b.x)], 1u);
    return b;
}
__device__ __forceinline__ void xcd_barrier_complete(unsigned* bar, unsigned x, unsigned& nloc, unsigned& nx) {
    const unsigned G = gridDim.x * gridDim.y * gridDim.z;
    unsigned sum, cnt, mine, sp = 0u;
    for (;;) {
        sum = 0u; cnt = 0u; mine = 0u;
#pragma unroll
        for (unsigned j = 0; j < 16; ++j) { const unsigned c = xb_ld(&bar[XB_XCNT(j)]); sum += c; cnt += (c > 0u) ? 1u : 0u; mine = (j == x) ? c : mine; }
        if (sum == G) break;
        __builtin_amdgcn_s_sleep(1);
        if ((++sp & 255u) == 0u) { if (xb_ld(&bar[XB_TMO])) break; if (sp > XB_SPIN_CAP) { atomicAdd(&bar[XB_TMO], 1u); break; } }
    }
    nloc = mine > 0u ? mine : 1u; nx = cnt > 0u ? cnt : 1u;
}

__device__ __forceinline__ void xcd_barrier(const XcdBarrier& b) {
    asm volatile("s_waitcnt vmcnt(0)" ::: "memory");
    __syncthreads();
    if (threadIdx.x == 0) {
        unsigned* bar = b.bar;
        __builtin_amdgcn_s_waitcnt(0);
        unsigned nloc = b.st[0], nx = b.st[1];
        if (nloc == 0u) { xcd_barrier_complete(bar, b.x, nloc, nx); b.st[0] = nloc; b.st[1] = nx; }
        const unsigned old = xb_add(&bar[XB_XSUB(b.x)], 1u);
        const unsigned gen = old / nloc;
        if (old + 1u == (gen + 1u) * nloc) {
            __builtin_amdgcn_fence(__ATOMIC_RELEASE, "agent");
            asm volatile("s_waitcnt vmcnt(0)" ::: "memory");
            const unsigned og = xb_add(&bar[XB_TOP], 1u);
            const unsigned tg = og / nx;
            if (og + 1u == (tg + 1u) * nx) xb_add(&bar[XB_TOPGEN], 1u);
            else XB_SPIN(xb_ld(&bar[XB_TOPGEN]) == tg, bar);
            __builtin_amdgcn_fence(__ATOMIC_ACQUIRE, "agent");
            xb_add(&bar[XB_XGEN(b.x)], 1u);
            asm volatile("s_waitcnt vmcnt(0)" ::: "memory");
        } else {
            XB_SPIN(xb_ld(&bar[XB_XGEN(b.x)]) == gen, bar);
            __builtin_amdgcn_fence(__ATOMIC_ACQUIRE, "agent");
            asm volatile("s_waitcnt vmcnt(0)" ::: "memory");
        }
    }
    __syncthreads();
}

constexpr int NWAVES = 8, NTHREADS = 512;
constexpr int LDS_BYTES = 147456;
constexpr size_t MiB = 1u << 20;
constexpr size_t WS_SSA = 1 * MiB, WS_SSB = 3 * MiB, WS_QKSS = 5 * MiB;
constexpr size_t WS_WIN = 10 * MiB, WS_WOA = 50 * MiB, WS_WOB = 54 * MiB, WS_WOUT = 58 * MiB;
constexpr size_t WS_W2GU = 66 * MiB, WS_W2D = 110 * MiB, WS_XB = 66 * MiB;
constexpr size_t WS_W1GU = 132 * MiB, WS_W1D = 176 * MiB, WS_QSB = 132 * MiB, WS_QCA = 164 * MiB, WS_X2B = 132 * MiB;
constexpr size_t WS_H = 198 * MiB, WS_KSB = 198 * MiB, WS_VSB = 230 * MiB, WS_KCA = 262 * MiB, WS_VCA = 294 * MiB, WS_G = 198 * MiB, WS_GATES = 326 * MiB;
constexpr size_t WS_END = 454 * MiB;
constexpr int NPH = 9;

__device__ __forceinline__ float wave_sum(float v) {
#pragma unroll
    for (int o = 1; o < 64; o <<= 1) v += __shfl_xor(v, o);
    return v;
}
__device__ __forceinline__ void tr_item(const float* W, int N, int K, bf16* WT, int k0, int n0, int drow0, const float* gain, LAS float* scr, int lane, int blk_nt = 0) {
    const int ko = lane >> 3, nq = lane & 7;
    const float* src = W + (size_t)(k0 + 8 * ko) * N + n0 + 4 * nq;
    f32x4 v[8];
#pragma unroll
    for (int j = 0; j < 8; ++j) v[j] = __builtin_nontemporal_load((const f32x4*)(src + (size_t)j * N));
    if (gain) { const f32x4 g0 = *(const f32x4*)(gain + k0 + 8 * ko), g1 = *(const f32x4*)(gain + k0 + 8 * ko + 4);
#pragma unroll
        for (int j = 0; j < 4; ++j) { v[j] = v[j] * g0[j]; v[4 + j] = v[4 + j] * g1[j]; } }
    const int nrow = drow0 + 4 * nq;
    bf16* dst = blk_nt ? WT + ((size_t)(nrow >> 8) * blk_nt + (k0 >> 6)) * 16384 + (size_t)(nrow & 255) * 64 + 8 * ko : WT + (size_t)nrow * K + k0 + 8 * ko;
    const size_t rstride = blk_nt ? 64 : (size_t)K;
#pragma unroll
    for (int i = 0; i < 4; ++i) { u32x4 o; o.x = pk2(v[0][i], v[1][i]); o.y = pk2(v[2][i], v[3][i]); o.z = pk2(v[4][i], v[5][i]); o.w = pk2(v[6][i], v[7][i]);
        *(u32x4*)(dst + (size_t)i * rstride) = o; }
}
__device__ __forceinline__ void tr_plain(const float* W, int K, int N, bf16* WT, const float* gain, LAS float* scr, int item, int lane, int pitch = 0, bool blk = false) {
    const int nblk = N / 32, kb = item / nblk, nb = item % nblk; tr_item(W, N, pitch ? pitch : K, WT, 64 * kb, 32 * nb, 32 * nb, gain, scr, lane, blk ? K / 64 : 0);
}
__device__ __forceinline__ void tr_gu(const float* Wg, const float* Wu, bf16* WT, const float* gain, LAS float* scr, int item, int lane) {
    constexpr int nblk = DFF / 32, per = (DM / 64) * nblk; const int mat = item / per, r = item % per, kb = r / nblk, n0 = 32 * (r % nblk);
    tr_item(mat ? Wu : Wg, DFF, DM, WT, 64 * kb, n0, 256 * (n0 >> 7) + 128 * mat + (n0 & 127), gain, scr, lane);
}

struct Args { const float* in[19]; float* out; unsigned char* ws; int ph_lo, ph_hi; };
static_assert(sizeof(Args) == 19 * 8 + 8 + 8 + 8, "Args has no padding");

__global__ void __launch_bounds__(NTHREADS, 2) fwd(Args args) {
    extern __shared__ __attribute__((aligned(16))) unsigned char lds_raw[];
    ldsp lds = (ldsp)lds_raw;
    const int tid = threadIdx.x, lane = tid & 63, wave = __builtin_amdgcn_readfirstlane(tid >> 6);
    const int G = gridDim.x, bx = blockIdx.x, vcu = (G % 8 == 0) ? (bx % 8) * (G / 8) + bx / 8 : bx;
    unsigned char* ws = args.ws;
    const float* x = args.in[0]; float* X = args.out;
#define ssA ((float*)(ws + WS_SSA))
#define ssB ((float*)(ws + WS_SSB))
#define qkss ((float*)(ws + WS_QKSS))
#define Win ((bf16*)(ws + WS_WIN))
#define WoA ((bf16*)(ws + WS_WOA))
#define WoB ((bf16*)(ws + WS_WOB))
#define Wout ((bf16*)(ws + WS_WOUT))
#define W2gu ((bf16*)(ws + WS_W2GU))
#define W2d ((bf16*)(ws + WS_W2D))
#define XB ((bf16*)(ws + WS_XB))
#define W1gu ((bf16*)(ws + WS_W1GU))
#define W1d ((bf16*)(ws + WS_W1D))
#define QSB ((bf16*)(ws + WS_QSB))
#define QCA (QSB + HW)
#define X2B ((bf16*)(ws + WS_X2B))
#define Hb ((bf16*)(ws + WS_H))
#define KSB ((bf16*)(ws + WS_KSB))
#define VSB ((bf16*)(ws + WS_VSB))
#define KCA ((bf16*)(ws + WS_KCA))
#define VCA ((bf16*)(ws + WS_VCA))
#define Gm ((bf16*)(ws + WS_G))
#define GATES ((bf16*)(ws + WS_GATES))
    const int lo = args.ph_lo, hi = args.ph_hi;
    cg::grid_group grid = cg::this_grid();
    volatile LAS unsigned* MISC = (volatile LAS unsigned*)(lds + 131072);
    if (tid < 64) MISC[tid] = 0u;
    __syncthreads();
    XcdBarrier xbar; xbar.bar = (unsigned*)ws; xbar.x = 0; xbar.st = MISC + 8;
    if (hi - lo > 1) xbar = xcd_barrier_post((unsigned*)ws, MISC + 8);
    if (lo < 0) grid.sync();
#ifndef PH_MASK
#define PH_MASK 0x3ff
#endif
#define IN(k) (((PH_MASK >> (k)) & 1) && lo <= (k) && (k) < hi)
#define SEAM(k) do { if (IN(k) && IN((k) + 1)) xcd_barrier(xbar); } while (0)
    const int gw = vcu * NWAVES + wave, NGW = G * NWAVES;
    LAS float* scr = (LAS float*)(lds + wave * 16384);

    if (IN(0)) {
        constexpr int I_GU = 2 * (DM / 64) * (DFF / 32), I_D = (DFF / 64) * (DM / 32), I_IN = (DM / 64) * (NIN / 32), I_O = (HW / 64) * (DM / 32), I_OUT = (DM / 64) * (DM / 32);
        constexpr int NITEMS = I_GU + I_D + I_IN + 2 * I_O + I_OUT;
        for (int it = gw; it < NITEMS; it += NGW) {
            int r = it;
            if (r < I_GU) { tr_gu(args.in[2], args.in[3], W1gu, args.in[1], scr, r, lane); continue; } r -= I_GU;
            if (r < I_D) { tr_plain(args.in[4], DFF, DM, W1d, nullptr, scr, r, lane, 0, true); continue; } r -= I_D;
            if (r < I_IN) { tr_plain(args.in[6], DM, NIN, Win, args.in[5], scr, r, lane); continue; } r -= I_IN;
            if (r < I_O) { tr_plain(args.in[11], HW, DM, WoA, nullptr, scr, r, lane, 2 * HW); continue; } r -= I_O;
            if (r < I_O) { tr_plain(args.in[12], HW, DM, WoA + HW, nullptr, scr, r, lane, 2 * HW); continue; } r -= I_O;
            tr_plain(args.in[13], DM, DM, Wout, nullptr, scr, r, lane);
        }
        for (int m = gw; m < M; m += NGW) {
            const f32x4* xr = (const f32x4*)(x + (size_t)m * DM) + lane; f32x4 v[8]; float s = 0.f;
#pragma unroll
            for (int j = 0; j < 8; ++j) { v[j] = xr[64 * j]; s += (v[j][0] * v[j][0] + v[j][1] * v[j][1]) + (v[j][2] * v[j][2] + v[j][3] * v[j][3]); }
            s = wave_sum(s);
            u32x2* o8 = (u32x2*)(XB + (size_t)m * DM) + lane;
#pragma unroll
            for (int j = 0; j < 8; ++j) { u32x2 w; w.x = pk2(v[j][0], v[j][1]); w.y = pk2(v[j][2], v[j][3]); o8[64 * j] = w; }
            if (lane < NSS) ssA[(size_t)m * NSS + lane] = (lane == 0) ? s : 0.f;
        }
    }
    SEAM(0);
    if (IN(1)) {
        pg8::Gemm g{XB, W1gu, M, 2 * DFF, DM}; pg8::StaticOrder S; S.init(M, 2 * DFF, G, bx);
        pg8::EpiSwiglu E{Hb, ssA};
        pg8::gemm_phase<pg8::EpiSwiglu, pg8::StaticOrder, true, true>(lds, g, S, E);
    }
    SEAM(1);
    if (IN(2)) {
        pg8::Gemm g{Hb, W1d, M, DM, DFF, true, true}; pg8::StaticOrder S; S.init(M, DM, G, bx);
        pg8::EpiResid<false> E{x, nullptr, (bf16*)X, ssB, 0.5f};
        pg8::gemm_phase<pg8::EpiResid<false>, pg8::StaticOrder, true, true>(lds, g, S, E);
    }
    SEAM(2);
    if (IN(3)) {
        pg8::Gemm g{(const bf16*)X, Win, M, NIN, DM}; pg8::StaticOrder S; S.init(M, NIN, G, bx);
        pg8::EpiIn E{QSB, KSB, VSB, QCA, KCA, VCA, GATES, qkss, ssB, args.in[7]};
        pg8::gemm_phase<pg8::EpiIn, pg8::StaticOrder, true, true>(lds, g, S, E);
    }
    SEAM(3);
    if (IN(4)) {
        att::Addr ad; att::addr_init(ad, lane);
        constexpr int I_GU = 2 * (DM / 64) * (DFF / 32), I_D = (DFF / 64) * (DM / 32);
        const int cslot = vcu % 3;
#define W2_COPIES() do { for (int it = gw; it < I_GU + I_D; it += NGW) { \
            if (it < I_GU) tr_gu(args.in[15], args.in[16], W2gu, args.in[14], scr, it, lane); \
            else tr_plain(args.in[17], DFF, DM, W2d, nullptr, scr, it - I_GU, lane, 0, true); } } while (0)
        if (cslot == 0) W2_COPIES();
        for (int u = vcu; u < 256; u += G) {
            const int bh = u >> 3, s = u & 7;
            att::sb_unit(bh >> 3, bh & 7, s, QSB, KSB, VSB, QSB, lds, ad);
            att::sb_unit(bh >> 3, bh & 7, 15 - s, QSB, KSB, VSB, QSB, lds, ad);
        }
        if (cslot == 1) W2_COPIES();
        for (int u = vcu; u < 512; u += G) {
            const int bh = u >> 4;
            att::ca_unit(bh >> 3, bh & 7, u & 15, QCA, KCA, VCA, QCA, qkss, args.in[8], args.in[9], args.in[10], lds, ad);
        }
        if (cslot == 2) W2_COPIES();
#undef W2_COPIES
    }
    SEAM(4);
    if (IN(5)) {
        pg8::Gemm g{QSB, WoA, M, DM, 2 * HW}; pg8::StaticOrder S; S.init(M, DM, G, bx); pg8::EpiGateF E{GATES, Gm};
        pg8::gemm_phase<pg8::EpiGateF, pg8::StaticOrder, true, true>(lds, g, S, E);
    }
    SEAM(5);
    if (IN(6)) {
        pg8::Gemm g{Gm, Wout, M, DM, DM}; pg8::StaticOrder S; S.init(M, DM, G, bx);
        pg8::EpiResid<true> E{(const bf16*)X, nullptr, X2B, ssA, 1.0f};
        pg8::gemm_phase<pg8::EpiResid<true>, pg8::StaticOrder, true, true>(lds, g, S, E);
    }
    SEAM(6);
    if (IN(7)) {
        pg8::Gemm g{X2B, W2gu, M, 2 * DFF, DM}; pg8::StaticOrder S; S.init(M, 2 * DFF, G, bx);
        pg8::EpiSwiglu E{Hb, ssA};
        pg8::gemm_phase<pg8::EpiSwiglu, pg8::StaticOrder, true, true>(lds, g, S, E);
    }
    SEAM(7);
    if (IN(8)) {
        pg8::Gemm g{Hb, W2d, M, DM, DFF, true, true};
        pg8::PanelOrder S; S.init(bx);
        pg8::EpiFinal E{X2B, X, args.in[18], (float*)(ws + 512 * 1024), (unsigned*)(ws + 32 * 1024), lds + 132096, 0.5f};
        pg8::gemm_phase<pg8::EpiFinal, pg8::PanelOrder, true, true>(lds, g, S, E);
    }
#undef IN
#undef SEAM
}

extern "C" void kernel_launch(void* const* d_in, const int* in_sizes, int n_in, void* d_out, int out_size, void* d_ws, size_t ws_size, hipStream_t stream) {
    static int grid = 0;
    if (grid == 0) {
        if (n_in != 19 || in_sizes[0] != M * DM || out_size != M * DM || ws_size < WS_END) { fprintf(stderr, "kernel_launch: unexpected shapes / workspace (n_in %d, ws %zu)\n", n_in, ws_size); grid = -1; return; }
        int dev = 0, cus = 0, per_cu = 0;
        if (hipGetDevice(&dev) != hipSuccess || hipDeviceGetAttribute(&cus, hipDeviceAttributeMultiprocessorCount, dev) != hipSuccess) { grid = -1; return; }
        if (hipFuncSetAttribute((const void*)fwd, hipFuncAttributeMaxDynamicSharedMemorySize, LDS_BYTES) != hipSuccess) { fprintf(stderr, "kernel_launch: hipFuncSetAttribute failed\n"); grid = -1; return; }
        if (hipOccupancyMaxActiveBlocksPerMultiprocessor(&per_cu, (const void*)fwd, NTHREADS, LDS_BYTES) != hipSuccess || per_cu < 1) { fprintf(stderr, "kernel_launch: occupancy query gave %d\n", per_cu); per_cu = 1; }
        (void)hipGetLastError();
        grid = cus * per_cu;
        if (grid != 256) { fprintf(stderr, "kernel_launch: this kernel needs exactly 256 resident workgroups (one per CU of a 256-CU MI355X); got %d; nothing launched\n", grid); grid = -1; return; }
    }
    if (grid < 0) return;
    if (hipMemsetAsync(d_ws, 0, 65536, stream) != hipSuccess) { fprintf(stderr, "kernel_launch: memset failed\n"); return; }
    Args a{};
    for (int i = 0; i < 19; ++i) a.in[i] = (const float*)d_in[i];
    a.out = (float*)d_out; a.ws = (unsigned char*)d_ws;
#if MK_MULTI
    for (int p = 0; p < NPH; ++p) { a.ph_lo = p; a.ph_hi = p + 1; hipLaunchKernelGGL(fwd, dim3(grid), dim3(NTHREADS), LDS_BYTES, stream, a); }
#else
    a.ph_lo = 0; a.ph_hi = NPH;
    void* kargs[] = {&a};
    hipError_t e = hipLaunchCooperativeKernel((const void*)fwd, dim3(grid), dim3(NTHREADS), kargs, LDS_BYTES, stream);
    if (e != hipSuccess) fprintf(stderr, "kernel_launch: cooperative launch failed: %s (grid %d)\n", hipGetErrorString(e), grid);
#ifdef PROBE_EXTRA
    { static const int kExtra[] = {PROBE_EXTRA}; Args p = a; p.out = (float*)((unsigned char*)d_ws + WS_GATES);
      for (unsigned i = 0; i < sizeof(kExtra) / sizeof(kExtra[0]); ++i) { p.ph_lo = kExtra[i]; p.ph_hi = kExtra[i] + 1; hipLaunchKernelGGL(fwd, dim3(grid), dim3(NTHREADS), LDS_BYTES, stream, p); } }
#endif
#endif
}
```

```cpp
#include <hip/hip_runtime.h>
#include <hip/hip_cooperative_groups.h>
#include <cstdio>
#include <cstdint>
namespace cg = cooperative_groups;
#ifndef MK_MULTI
#define MK_MULTI 0
#endif
namespace pg8 {
#define PG8_LAS __attribute__((address_space(3)))
typedef unsigned short bf16_t;
typedef short bf16x8 __attribute__((ext_vector_type(8)));
typedef float f32x4 __attribute__((ext_vector_type(4)));
typedef unsigned u32x4 __attribute__((ext_vector_type(4)));
constexpr int BM = 256, BK = 64, HALF = 128, HTB = HALF * BK * 2  , STAGE_BYTES = 8 * HTB, NXCD = 8, WGM = 4;

__host__ __device__ __forceinline__ int lds_byte(int r, int c) { const int st = (r >> 4) * 2 + (c >> 5), rr = r & 15, cc = c & 31, ob = rr * 64 + cc * 2; return st * 1024 + (ob ^ (((ob >> 9) & 1) << 5)); }
__host__ __device__ __forceinline__ void stage_rc(int b, int& R, int& C) { const int st = b / 1024, sb = b % 1024, swz = sb ^ (((sb >> 9) & 1) << 5); R = (st >> 1) * 16 + swz / 64; C = (st & 1) * 32 + (swz % 64) / 2; }
__host__ __device__ __forceinline__ int perm32(int rho) { const int n = rho >> 4, i = rho & 15; return 8 * (i >> 2) + 4 * n + (i & 3); }

struct Unit { int pm, pn; };
struct Gemm { const bf16_t* A; const bf16_t* Bt; int M, N, K; bool ablk = false, bblk = false; };

struct StaticOrder {
    int nM, nN, nwg, G, c;
    __host__ __device__ void init(int M, int N, int G_, int c_) { nM = M / BM; nN = N / BM; nwg = nM * nN; G = G_; c = c_; }
    __host__ __device__ bool next(int i, Unit& u) const {
        const long L = (long)i * G + c; if (L >= nwg) return false;
        int wgid = (int)L; { const int q = nwg / NXCD, r = nwg % NXCD, xcd = wgid % NXCD, off = wgid / NXCD; wgid = (xcd < r ? xcd * (q + 1) : r * (q + 1) + (xcd - r) * q) + off; }
        const int nig = WGM * nN, gid = wgid / nig, fm = gid * WGM, gsz = (nM - fm) < WGM ? (nM - fm) : WGM;
        u.pm = fm + ((wgid % nig) % gsz); u.pn = (wgid % nig) / gsz; return true;
    }
    __device__ __forceinline__ void a_ready(const Unit&) const {}
    __device__ __forceinline__ void done(const Unit&) const {}
};

__device__ __forceinline__ unsigned cvt_pk_bf16(float lo, float hi) { unsigned r; asm volatile("v_cvt_pk_bf16_f32 %0, %1, %2" : "=v"(r) : "v"(lo), "v"(hi)); return r; }
typedef float f32x2 __attribute__((ext_vector_type(2)));
template <class Epi, class Sched, bool ALIGN_EPI = false, bool SP2 = false>
__device__ __forceinline__ void gemm_phase(PG8_LAS unsigned char* lds, const Gemm g, const Sched& S, const Epi& E) {
    const int tid = threadIdx.x, wid = __builtin_amdgcn_readfirstlane(tid >> 6), lane = tid & 63, wr = wid >> 2, wc = wid & 3, fr = lane & 15, fq = lane >> 4;
    const int K = g.K, nt = K / BK;
    unsigned voffA[2], voffB[2];
#pragma unroll
    for (int i = 0; i < 2; ++i) { int R, C; stage_rc(tid * 16 + i * 8192, R, C); const int Rb = Epi::PERM ? ((R & ~31) + perm32(R & 31)) : R;
        voffA[i] = (unsigned)(R * (g.ablk ? BK : K) + C) * 2u; voffB[i] = (unsigned)(Rb * (g.bblk ? BK : K) + C) * 2u; }
    const size_t kstA = g.ablk ? (size_t)(BM * BK * 2) : (size_t)(BK * 2), kstB = g.bblk ? (size_t)(BM * BK * 2) : (size_t)(BK * 2);
    const size_t hstA = g.ablk ? (size_t)(HALF * BK * 2) : (size_t)HALF * K * 2, hstB = g.bblk ? (size_t)(HALF * BK * 2) : (size_t)HALF * K * 2;
    const size_t tstA = (size_t)BM * K * 2, tstB = (size_t)BM * K * 2;
    const unsigned ldsw = (unsigned)wid * 1024u;
    const int aoff = lds_byte(wr * 64 + fr, fq * 8), boff = lds_byte(wc * 32 + fr, fq * 8);
#define PG8_SA(b, h) (((b) * 2 + (h)) * HTB)
#define PG8_SB(b, h) ((4 + (b) * 2 + (h)) * HTB)
#define PG8_STAGE(bufoff, gbase, voff) do { _Pragma("unroll") for (int _i = 0; _i < 2; ++_i) \
        __builtin_amdgcn_global_load_lds((const unsigned*)((const char*)(gbase) + (voff)[_i]), (PG8_LAS unsigned*)(lds + (bufoff) + ldsw + _i * 8192), 16, 0, 0); } while (0)
#define PG8_LDA(dst, b, h) do { _Pragma("unroll") for (int m = 0; m < 4; ++m) _Pragma("unroll") for (int k = 0; k < 2; ++k) dst[m][k] = *(const PG8_LAS bf16x8*)(lds + PG8_SA(b, h) + aoff + m * 2048 + k * 1024); } while (0)
#define PG8_LDB(dst, b, h) do { _Pragma("unroll") for (int n = 0; n < 2; ++n) _Pragma("unroll") for (int k = 0; k < 2; ++k) dst[n][k] = *(const PG8_LAS bf16x8*)(lds + PG8_SB(b, h) + boff + n * 2048 + k * 1024); } while (0)
#define PG8_MMA(ai, bj, At, Bt) do { __builtin_amdgcn_s_setprio(1); _Pragma("unroll") for (int m = 0; m < 4; ++m) _Pragma("unroll") for (int n = 0; n < 2; ++n) _Pragma("unroll") for (int k = 0; k < 2; ++k) \
        acc[ai][bj][m][n] = __builtin_amdgcn_mfma_f32_16x16x32_bf16(Bt[n][k], At[m][k], acc[ai][bj][m][n], 0, 0, 0); __builtin_amdgcn_s_setprio(0); } while (0)
#define PG8_WAIT_V(n) asm volatile("s_waitcnt vmcnt(" #n ")" ::: "memory")
#define PG8_WAIT_L(n) asm volatile("s_waitcnt lgkmcnt(" #n ")" ::: "memory")
#define PG8_BAR __builtin_amdgcn_s_barrier()
#define PG8_SCHED __builtin_amdgcn_sched_barrier(0)
    Unit cur, nxt; int ui = 0;
    if (!S.next(0, cur)) return;
    f32x4 acc[2][2][4][2];
#pragma unroll
    for (int a = 0; a < 2; ++a)
#pragma unroll
        for (int b = 0; b < 2; ++b)
#pragma unroll
            for (int m = 0; m < 4; ++m)
#pragma unroll
                for (int n = 0; n < 2; ++n) acc[a][b][m][n] = (f32x4){0.f, 0.f, 0.f, 0.f};
    bf16x8 At[4][2], B0[2][2], B1[2][2];
    const char* cA = (const char*)g.A + (size_t)cur.pm * tstA; const char* cB = (const char*)g.Bt + (size_t)cur.pn * tstB;
    S.a_ready(cur);
    if constexpr (SP2) {
        PG8_STAGE(PG8_SB(0, 0), cB, voffB); PG8_STAGE(PG8_SB(0, 1), cB + hstB, voffB); PG8_STAGE(PG8_SA(0, 0), cA, voffA); PG8_STAGE(PG8_SA(0, 1), cA + hstA, voffA);
        if (wr == 1) PG8_BAR;
        PG8_WAIT_V(2); PG8_BAR;
        PG8_STAGE(PG8_SB(1, 0), cB + kstB, voffB); PG8_STAGE(PG8_SA(1, 0), cA + kstA, voffA); PG8_STAGE(PG8_SB(1, 1), cB + hstB + kstB, voffB);
        PG8_WAIT_V(6); PG8_BAR;
    } else {
        PG8_STAGE(PG8_SB(0, 0), cB, voffB); PG8_STAGE(PG8_SA(0, 0), cA, voffA); PG8_STAGE(PG8_SB(0, 1), cB + hstB, voffB); PG8_STAGE(PG8_SA(0, 1), cA + hstA, voffA);
        if (wr == 1) PG8_BAR;
        PG8_WAIT_V(4); PG8_BAR;
        PG8_STAGE(PG8_SB(1, 0), cB + kstB, voffB); PG8_STAGE(PG8_SA(1, 0), cA + kstA, voffA); PG8_STAGE(PG8_SB(1, 1), cB + hstB + kstB, voffB);
        PG8_WAIT_V(6); PG8_BAR;
    }
    for (;;) {
        const bool has_next = S.next(ui + 1, nxt);
        const char* nA = has_next ? (const char*)g.A + (size_t)nxt.pm * tstA : cA; const char* nB = has_next ? (const char*)g.Bt + (size_t)nxt.pn * tstB : cB;
        for (int t = 0; t < nt; t += 2) {
            const bool last = (t == nt - 2);
            const char* a1 = cA + (size_t)(t + 1) * kstA;
            const char* a2 = last ? nA : cA + (size_t)(t + 2) * kstA; const char* b2 = last ? nB : cB + (size_t)(t + 2) * kstB;
            const char* a3 = a2 + kstA; const char* b3 = b2 + kstB;
            if (last && has_next) S.a_ready(nxt);
            if constexpr (SP2) {
            PG8_LDB(B0, 0, 0); PG8_LDB(B1, 0, 1); PG8_SCHED; PG8_LDA(At, 0, 0); PG8_STAGE(PG8_SA(1, 1), a1 + hstA, voffA);
            PG8_WAIT_V(8); PG8_WAIT_L(0); PG8_BAR; PG8_MMA(0, 0, At, B0); PG8_MMA(0, 1, At, B1); PG8_BAR; PG8_SCHED;
            PG8_LDA(At, 0, 1); PG8_STAGE(PG8_SB(0, 0), b2, voffB); PG8_STAGE(PG8_SB(0, 1), b2 + hstB, voffB); PG8_STAGE(PG8_SA(0, 0), a2, voffA);
            PG8_WAIT_V(8); PG8_WAIT_L(0); PG8_BAR; PG8_MMA(1, 0, At, B0); PG8_MMA(1, 1, At, B1); PG8_BAR; PG8_SCHED;
            PG8_LDB(B0, 1, 0); PG8_LDB(B1, 1, 1); PG8_SCHED; PG8_LDA(At, 1, 0); PG8_STAGE(PG8_SA(0, 1), a2 + hstA, voffA);
            PG8_WAIT_V(8); PG8_WAIT_L(0); PG8_BAR; PG8_MMA(0, 0, At, B0); PG8_MMA(0, 1, At, B1); PG8_BAR; PG8_SCHED;
            PG8_LDA(At, 1, 1); PG8_STAGE(PG8_SB(1, 0), b3, voffB); PG8_STAGE(PG8_SB(1, 1), b3 + hstB, voffB); PG8_STAGE(PG8_SA(1, 0), a3, voffA);
            PG8_WAIT_V(8); PG8_WAIT_L(0); PG8_BAR; PG8_MMA(1, 0, At, B0); PG8_MMA(1, 1, At, B1); PG8_BAR; PG8_SCHED;
            } else {
            PG8_LDB(B0, 0, 0); PG8_SCHED; PG8_LDA(At, 0, 0); PG8_STAGE(PG8_SA(1, 1), a1 + hstA, voffA);
            PG8_WAIT_L(8); PG8_BAR; PG8_WAIT_L(0); PG8_MMA(0, 0, At, B0); PG8_BAR; PG8_SCHED;
            PG8_LDB(B1, 0, 1); PG8_STAGE(PG8_SB(0, 0), b2, voffB);
            PG8_BAR; PG8_WAIT_L(0); PG8_MMA(0, 1, At, B1); PG8_BAR;
            PG8_LDA(At, 0, 1); PG8_STAGE(PG8_SA(0, 0), a2, voffA);
            PG8_BAR; PG8_WAIT_L(0); PG8_MMA(1, 0, At, B0); PG8_BAR; PG8_SCHED;
            PG8_STAGE(PG8_SB(0, 1), b2 + hstB, voffB);
            PG8_WAIT_V(6); PG8_BAR; PG8_MMA(1, 1, At, B1); PG8_BAR;
            PG8_LDB(B0, 1, 0); PG8_SCHED; PG8_LDA(At, 1, 0); PG8_STAGE(PG8_SA(0, 1), a2 + hstA, voffA);
            PG8_WAIT_L(8); PG8_BAR; PG8_WAIT_L(0); PG8_MMA(0, 0, At, B0); PG8_BAR; PG8_SCHED;
            PG8_LDB(B1, 1, 1); PG8_STAGE(PG8_SB(1, 0), b3, voffB);
            PG8_BAR; PG8_WAIT_L(0); PG8_MMA(0, 1, At, B1); PG8_BAR;
            PG8_LDA(At, 1, 1); PG8_STAGE(PG8_SA(1, 0), a3, voffA);
            PG8_BAR; PG8_WAIT_L(0); PG8_MMA(1, 0, At, B0); PG8_BAR; PG8_SCHED;
            PG8_STAGE(PG8_SB(1, 1), b3 + hstB, voffB);
            PG8_WAIT_V(6); PG8_BAR; PG8_MMA(1, 1, At, B1); PG8_BAR;
            }
            if constexpr (Epi::MID_T >= 0) { if (t == Epi::MID_T) E.mid(acc, cur, wr, wc, fr, fq); }
        }
        if constexpr (ALIGN_EPI) { if (wr == 0) PG8_BAR; }
        if constexpr (!Epi::AFTER_DRAIN) { E(acc, cur, wr, wc, fr, fq); S.done(cur); }
        if (!has_next) break;
#pragma unroll
        for (int a = 0; a < 2; ++a)
#pragma unroll
            for (int b = 0; b < 2; ++b)
#pragma unroll
                for (int m = 0; m < 4; ++m)
#pragma unroll
                    for (int n = 0; n < 2; ++n) acc[a][b][m][n] = (f32x4){0.f, 0.f, 0.f, 0.f};
        cur = nxt; cA = nA; cB = nB; ++ui;
        if constexpr (ALIGN_EPI) { if (wr == 1) PG8_BAR; }
    }
    PG8_WAIT_V(0);
    if constexpr (!ALIGN_EPI) { if (wr == 0) PG8_BAR; }
    PG8_BAR;
    if constexpr (Epi::AFTER_DRAIN) { E.fused(acc, cur, wr, wc, fr, fq, lds, wid, lane); S.done(cur); }
#undef PG8_SA
#undef PG8_SB
#undef PG8_STAGE
#undef PG8_LDA
#undef PG8_LDB
#undef PG8_MMA
#undef PG8_WAIT_V
#undef PG8_WAIT_L
#undef PG8_BAR
#undef PG8_SCHED
}
}

constexpr int M = 16384, SEQ = 4096, DM = 2048, DFF = 5632, NIN = 10240, HW = 1024, NSS = 32, QP = 2048;
constexpr float EPS = 1e-6f, LOG2E = 1.4426950408889634f;
constexpr float C2 = 0.08838834764831845f * 1.4426950408889634f;

typedef unsigned short bf16;
typedef unsigned u32x4 __attribute__((ext_vector_type(4)));
typedef unsigned u32x2 __attribute__((ext_vector_type(2)));
typedef float f32x4 __attribute__((ext_vector_type(4)));
typedef float f32x16 __attribute__((ext_vector_type(16)));
typedef short bf16x8 __attribute__((ext_vector_type(8)));
typedef short s16x4 __attribute__((ext_vector_type(4)));
#define LAS __attribute__((address_space(3)))
typedef LAS unsigned char* ldsp;

__device__ __forceinline__ float bflo(unsigned w) { return __uint_as_float(w << 16); }
__device__ __forceinline__ float bfhi(unsigned w) { return __uint_as_float(w & 0xffff0000u); }
__device__ __forceinline__ unsigned pk2(float lo, float hi) { return pg8::cvt_pk_bf16(lo, hi); }
__device__ __forceinline__ float fast_sigmoid(float v) { return __builtin_amdgcn_rcpf(1.0f + __builtin_amdgcn_exp2f(-v * LOG2E)); }

namespace pg8 {
__device__ __forceinline__ float row_rstd(const float* ss, int row, int fq) {
    const f32x4* p = (const f32x4*)(ss + (size_t)row * NSS + 8 * fq);
    const f32x4 a = p[0], b = p[1];
    float s = ((a[0] + a[1]) + (a[2] + a[3])) + ((b[0] + b[1]) + (b[2] + b[3]));
    s += __shfl_xor(s, 16); s += __shfl_xor(s, 32);
    return rsqrtf(s * (1.0f / DM) + EPS);
}
__device__ __forceinline__ void rstd8(const float* ss, int row0, int fq, float (&rsv)[8]) {
#pragma unroll
    for (int i = 0; i < 8; ++i) rsv[i] = row_rstd(ss, row0 + (i >> 2) * HALF + (i & 3) * 16, fq);
}
struct EpiSwiglu {
    static constexpr bool PERM = true, AFTER_DRAIN = false; static constexpr int MID_T = -1;
    bf16_t* H; const float* ss; mutable int cpm = -1; mutable float rsv[8] = {};
    __device__ __forceinline__ void operator()(const f32x4 (&acc)[2][2][4][2], const Unit& u, int wr, int wc, int fr, int fq) const {
        const int row0 = u.pm * BM + wr * 64 + fr, col0 = u.pn * 128 + wc * 32 + 8 * fq;
        if (u.pm != cpm) { cpm = u.pm; rstd8(ss, row0, fq, rsv); }
#pragma unroll
        for (int ai = 0; ai < 2; ++ai)
#pragma unroll
            for (int m = 0; m < 4; ++m) {
                const int row = row0 + ai * HALF + m * 16; const float rs = rsv[ai * 4 + m];
                float hv[8];
#pragma unroll
                for (int n = 0; n < 2; ++n)
#pragma unroll
                    for (int e = 0; e < 4; ++e) { const float g = acc[ai][0][m][n][e] * rs, uu = acc[ai][1][m][n][e] * rs; hv[n * 4 + e] = g * fast_sigmoid(g) * uu; }
                u32x4 w; w.x = cvt_pk_bf16(hv[0], hv[1]); w.y = cvt_pk_bf16(hv[2], hv[3]); w.z = cvt_pk_bf16(hv[4], hv[5]); w.w = cvt_pk_bf16(hv[6], hv[7]);
                *(u32x4*)(H + (((size_t)(row >> 8) * (DFF / 64) + (col0 >> 6)) * 256 + (row & 255)) * 64 + (col0 & 63)) = w;
            }
    }
};
template <bool RESBF> struct EpiResid {
    static constexpr bool PERM = true, AFTER_DRAIN = false; static constexpr int MID_T = -1;
    const void* res; float* out; bf16_t* xb; float* ss; float alpha;
    __device__ __forceinline__ void operator()(const f32x4 (&acc)[2][2][4][2], const Unit& u, int wr, int wc, int fr, int fq) const {
        const int row0 = u.pm * BM + wr * 64 + fr, col0 = u.pn * BM + wc * 32 + 8 * fq;
#pragma unroll
        for (int ai = 0; ai < 2; ++ai)
#pragma unroll
            for (int m = 0; m < 4; ++m) {
                const int row = row0 + ai * HALF + m * 16; const size_t off = (size_t)row * DM + col0; float s = 0.f;
#pragma unroll
                for (int bj = 0; bj < 2; ++bj) {
                    f32x4 r0, r1;
                    if (RESBF) { const u32x4 p = *(const u32x4*)((const bf16_t*)res + off + bj * HALF); r0 = (f32x4){bflo(p.x), bfhi(p.x), bflo(p.y), bfhi(p.y)}; r1 = (f32x4){bflo(p.z), bfhi(p.z), bflo(p.w), bfhi(p.w)}; }
                    else { r0 = *(const f32x4*)((const float*)res + off + bj * HALF); r1 = *(const f32x4*)((const float*)res + off + bj * HALF + 4); }
                    const f32x4 v0 = r0 + acc[ai][bj][m][0] * alpha, v1 = r1 + acc[ai][bj][m][1] * alpha;
                    if (out) { *(f32x4*)(out + off + bj * HALF) = v0; *(f32x4*)(out + off + bj * HALF + 4) = v1; }
                    s += ((v0[0] * v0[0] + v0[1] * v0[1]) + (v0[2] * v0[2] + v0[3] * v0[3])) + ((v1[0] * v1[0] + v1[1] * v1[1]) + (v1[2] * v1[2] + v1[3] * v1[3]));
                    if (xb) { u32x4 w; w.x = cvt_pk_bf16(v0[0], v0[1]); w.y = cvt_pk_bf16(v0[2], v0[3]); w.z = cvt_pk_bf16(v1[0], v1[1]); w.w = cvt_pk_bf16(v1[2], v1[3]); *(u32x4*)(xb + off + bj * HALF) = w; }
                }
                s += __shfl_xor(s, 16); s += __shfl_xor(s, 32);
                if (fq == 0) ss[(size_t)row * NSS + u.pn * 4 + wc] = s;
            }
    }
};
struct EpiIn {
    static constexpr bool PERM = true, AFTER_DRAIN = false; static constexpr int MID_T = -1;
    bf16_t *qsb, *ksb, *vsb, *qca, *kca, *vca, *gates; float* qkss; const float* ss; const float* bgate; const PG8_LAS float* rtab; int pmA;
    __device__ __forceinline__ void operator()(const f32x4 (&acc)[2][2][4][2], const Unit& u, int wr, int wc, int fr, int fq) const {
        const int row0 = u.pm * BM + wr * 64 + fr; const int pn = u.pn;
        if (pn < 24) {
            const int t = pn >> 2; bf16_t* dst = t == 0 ? qsb : t == 1 ? ksb : t == 2 ? vsb : t == 3 ? qca : t == 4 ? kca : vca;
            const float sc = (t == 0) ? C2 : 1.0f; const bool stat = (t == 3 || t == 4);
            const int col0 = (pn & 3) * BM + wc * 32 + 8 * fq;
#pragma unroll
            for (int ai = 0; ai < 2; ++ai)
#pragma unroll
                for (int m = 0; m < 4; ++m) {
                    const int row = row0 + ai * HALF + m * 16; const float rs = rtab[(u.pm == pmA ? 0 : 256) + wr * 64 + fr + ai * HALF + m * 16] * sc;
#pragma unroll
                    for (int bj = 0; bj < 2; ++bj) {
                        const f32x4 v0 = acc[ai][bj][m][0] * rs, v1 = acc[ai][bj][m][1] * rs;
                        u32x4 w; w.x = cvt_pk_bf16(v0[0], v0[1]); w.y = cvt_pk_bf16(v0[2], v0[3]); w.z = cvt_pk_bf16(v1[0], v1[1]); w.w = cvt_pk_bf16(v1[2], v1[3]);
                        *(u32x4*)(dst + (size_t)row * ((t == 0 || t == 3) ? QP : HW) + col0 + bj * HALF) = w;
                        if (stat) {
                            float s = ((v0[0] * v0[0] + v0[1] * v0[1]) + (v0[2] * v0[2] + v0[3] * v0[3])) + ((v1[0] * v1[0] + v1[1] * v1[1]) + (v1[2] * v1[2] + v1[3] * v1[3]));
                            s += __shfl_xor(s, 16); s += __shfl_xor(s, 32);
                            if (fq == 0) qkss[(size_t)row * 64 + ((t - 3) * 8 + (pn & 3) * 2 + bj) * 4 + wc] = s;
                        }
                    }
                }
        } else {
            const int col0 = (pn - 24) * BM + wc * 32 + 8 * fq;
            f32x4 bv[2][2];
#pragma unroll
            for (int bj = 0; bj < 2; ++bj)
#pragma unroll
                for (int n = 0; n < 2; ++n) bv[bj][n] = *(const f32x4*)(bgate + col0 + bj * HALF + 4 * n);
#pragma unroll
            for (int ai = 0; ai < 2; ++ai)
#pragma unroll
                for (int m = 0; m < 4; ++m) {
                    const int row = row0 + ai * HALF + m * 16; const float rs = rtab[(u.pm == pmA ? 0 : 256) + wr * 64 + fr + ai * HALF + m * 16];
#pragma unroll
                    for (int bj = 0; bj < 2; ++bj) {
                        const f32x4 v0 = acc[ai][bj][m][0] * rs + bv[bj][0], v1 = acc[ai][bj][m][1] * rs + bv[bj][1];
                        u32x4 w; w.x = cvt_pk_bf16(fast_sigmoid(v0[0]), fast_sigmoid(v0[1])); w.y = cvt_pk_bf16(fast_sigmoid(v0[2]), fast_sigmoid(v0[3]));
                        w.z = cvt_pk_bf16(fast_sigmoid(v1[0]), fast_sigmoid(v1[1])); w.w = cvt_pk_bf16(fast_sigmoid(v1[2]), fast_sigmoid(v1[3]));
                        *(u32x4*)(gates + (size_t)row * (2 * DM) + col0 + bj * HALF) = w;
                    }
                }
        }
    }
};
struct EpiGateF {
    static constexpr bool PERM = true, AFTER_DRAIN = false; static constexpr int MID_T = 14;
    const bf16_t* gates; bf16_t* G;
    __device__ __forceinline__ void mid(f32x4 (&acc)[2][2][4][2], const Unit& u, int wr, int wc, int fr, int fq) const {
        asm volatile("" : "+v"(fr), "+v"(fq));
        const int row0 = u.pm * BM + wr * 64 + fr, col0 = u.pn * BM + wc * 32 + 8 * fq;
#pragma unroll
        for (int ai = 0; ai < 2; ++ai)
#pragma unroll
            for (int m = 0; m < 4; ++m) {
                const int row = row0 + ai * HALF + m * 16;
#pragma unroll
                for (int bj = 0; bj < 2; ++bj) {
                    const bf16_t* gp = gates + (size_t)row * (2 * DM) + col0 + bj * HALF;
                    const u32x4 ga = *(const u32x4*)gp, gb = *(const u32x4*)(gp + DM);
                    const float ra[8] = {bflo(ga.x), bfhi(ga.x), bflo(ga.y), bfhi(ga.y), bflo(ga.z), bfhi(ga.z), bflo(ga.w), bfhi(ga.w)};
                    const float rb[8] = {bflo(gb.x), bfhi(gb.x), bflo(gb.y), bfhi(gb.y), bflo(gb.z), bfhi(gb.z), bflo(gb.w), bfhi(gb.w)};
#pragma unroll
                    for (int e = 0; e < 4; ++e) { acc[ai][bj][m][0][e] *= ra[e] * __builtin_amdgcn_rcpf(__builtin_fmaxf(rb[e], 1e-30f)); acc[ai][bj][m][1][e] *= ra[4 + e] * __builtin_amdgcn_rcpf(__builtin_fmaxf(rb[4 + e], 1e-30f)); }
                }
                if (m & 1) asm volatile("" ::: "memory");
            }
    }
    __device__ __forceinline__ void operator()(const f32x4 (&acc)[2][2][4][2], const Unit& u, int wr, int wc, int fr, int fq) const {
        const int row0 = u.pm * BM + wr * 64 + fr, col0 = u.pn * BM + wc * 32 + 8 * fq;
#pragma unroll
        for (int ai = 0; ai < 2; ++ai)
#pragma unroll
            for (int m = 0; m < 4; ++m) {
                const int row = row0 + ai * HALF + m * 16;
#pragma unroll
                for (int bj = 0; bj < 2; ++bj) {
                    const u32x4 gb = *(const u32x4*)(gates + (size_t)row * (2 * DM) + DM + col0 + bj * HALF);
                    const f32x4 a0 = acc[ai][bj][m][0], a1 = acc[ai][bj][m][1];
                    const float v[8] = {__builtin_fmaxf(bflo(gb.x), 1e-30f) * a0[0], __builtin_fmaxf(bfhi(gb.x), 1e-30f) * a0[1], __builtin_fmaxf(bflo(gb.y), 1e-30f) * a0[2], __builtin_fmaxf(bfhi(gb.y), 1e-30f) * a0[3],
                                        __builtin_fmaxf(bflo(gb.z), 1e-30f) * a1[0], __builtin_fmaxf(bfhi(gb.z), 1e-30f) * a1[1], __builtin_fmaxf(bflo(gb.w), 1e-30f) * a1[2], __builtin_fmaxf(bfhi(gb.w), 1e-30f) * a1[3]};
                    u32x4 w; w.x = cvt_pk_bf16(v[0], v[1]); w.y = cvt_pk_bf16(v[2], v[3]); w.z = cvt_pk_bf16(v[4], v[5]); w.w = cvt_pk_bf16(v[6], v[7]);
                    *(u32x4*)(G + (size_t)row * DM + col0 + bj * HALF) = w;
                }
            }
    }
};
struct PanelOrder {
    int c;
    __host__ __device__ void init(int c_) { c = c_; }
    __host__ __device__ bool next(int i, Unit& u) const { if (i >= 2) return false; const int xcd = c & 7, idx = c >> 3; u.pm = 32 * i + 4 * xcd + (idx >> 3); u.pn = idx & 7; return true; }
    __device__ __forceinline__ void a_ready(const Unit&) const {}
    __device__ __forceinline__ void done(const Unit&) const {}
};
struct EpiFinal {
    static constexpr bool PERM = true, AFTER_DRAIN = false; static constexpr int MID_T = -1;
    const bf16_t* res; float* out; const float* gain; float* xs; unsigned* cnt; PG8_LAS unsigned char* ldsx; float alpha;
    __device__ __forceinline__ void operator()(f32x4 (&acc)[2][2][4][2], const Unit& u, int wr, int wc, int fr, int fq) const {
        const int tid = threadIdx.x, lane = tid & 63, wid = __builtin_amdgcn_readfirstlane(tid >> 6);
        PG8_LAS float* P = (PG8_LAS float*)ldsx;
        PG8_LAS float* S = (PG8_LAS float*)(ldsx + 4096);
        const int rl0 = wr * 64 + fr, col0 = u.pn * BM + wc * 32 + 8 * fq;
#pragma unroll
        for (int ai = 0; ai < 2; ++ai)
#pragma unroll
            for (int m = 0; m < 4; ++m) {
                const int rl = rl0 + ai * HALF + m * 16; const size_t off = (size_t)(u.pm * BM + rl) * DM + col0; float s = 0.f;
#pragma unroll
                for (int bj = 0; bj < 2; ++bj) {
                    const u32x4 p = *(const u32x4*)(res + off + bj * HALF);
                    const f32x4 v0 = (f32x4){bflo(p.x), bfhi(p.x), bflo(p.y), bfhi(p.y)} + acc[ai][bj][m][0] * alpha, v1 = (f32x4){bflo(p.z), bfhi(p.z), bflo(p.w), bfhi(p.w)} + acc[ai][bj][m][1] * alpha;
                    acc[ai][bj][m][0] = v0; acc[ai][bj][m][1] = v1;
                    s += ((v0[0] * v0[0] + v0[1] * v0[1]) + (v0[2] * v0[2] + v0[3] * v0[3])) + ((v1[0] * v1[0] + v1[1] * v1[1]) + (v1[2] * v1[2] + v1[3] * v1[3]));
                }
                s += __shfl_xor(s, 16); s += __shfl_xor(s, 32);
                if (fq == 0) P[rl * 4 + wc] = s;
            }
        asm volatile("s_waitcnt lgkmcnt(0)" ::: "memory"); __builtin_amdgcn_s_barrier(); asm volatile("" ::: "memory");
        if (tid < 256) {
            const f32x4 t = *(const PG8_LAS f32x4*)(P + tid * 4);
            __hip_atomic_store(xs + ((size_t)(u.pm * BM + tid) * 8 + u.pn), (t[0] + t[1]) + (t[2] + t[3]), __ATOMIC_RELAXED, __HIP_MEMORY_SCOPE_AGENT);
        }
        asm volatile("s_waitcnt vmcnt(0)" ::: "memory");
        if (tid < 256 && lane == 0) __hip_atomic_fetch_add(cnt + 64 * u.pm, 1u, __ATOMIC_RELAXED, __HIP_MEMORY_SCOPE_AGENT);
        if (wid == 0) {
            unsigned spins = 0;
            while ((unsigned)__builtin_amdgcn_readfirstlane((int)__hip_atomic_load(cnt + 64 * u.pm, __ATOMIC_RELAXED, __HIP_MEMORY_SCOPE_AGENT)) < 32u) { __builtin_amdgcn_s_sleep(2); if (++spins > (1u << 22)) break; }
            __builtin_amdgcn_fence(__ATOMIC_ACQUIRE, "agent");
        }
        asm volatile("s_waitcnt vmcnt(0) lgkmcnt(0)" ::: "memory"); __builtin_amdgcn_s_barrier(); asm volatile("" ::: "memory");
        if (tid < 256) {
            const float* sl = xs + (size_t)(u.pm * BM + tid) * 8; float q = 0.f;
#pragma unroll
            for (int t = 0; t < 8; ++t) q += __hip_atomic_load(sl + t, __ATOMIC_RELAXED, __HIP_MEMORY_SCOPE_AGENT);
            S[tid] = rsqrtf(q * (1.0f / DM) + EPS);
        }
        asm volatile("s_waitcnt lgkmcnt(0)" ::: "memory"); __builtin_amdgcn_s_barrier(); asm volatile("" ::: "memory");
        f32x4 gv[2][2];
#pragma unroll
        for (int bj = 0; bj < 2; ++bj)
#pragma unroll
            for (int n = 0; n < 2; ++n) gv[bj][n] = *(const f32x4*)(gain + col0 + bj * HALF + 4 * n);
#pragma unroll
        for (int ai = 0; ai < 2; ++ai)
#pragma unroll
            for (int m = 0; m < 4; ++m) {
                const int rl = rl0 + ai * HALF + m * 16; const size_t off = (size_t)(u.pm * BM + rl) * DM + col0; const float rs = S[rl];
#pragma unroll
                for (int bj = 0; bj < 2; ++bj) { *(f32x4*)(out + off + bj * HALF) = acc[ai][bj][m][0] * rs * gv[bj][0]; *(f32x4*)(out + off + bj * HALF + 4) = acc[ai][bj][m][1] * rs * gv[bj][1]; }
            }
    }
};
}

namespace att {
constexpr int KB0 = 0, VB0 = 32768, TILEB = 16384, WSC = 65536, RELB = 67584, GQK = 68608, KSC = 69632, DONE = 70656;
__device__ __forceinline__ unsigned off_b(unsigned row, unsigned ch) { return 256u * row + 16u * (ch ^ (((row & 3) << 2) | ((row >> 2) & 3))); }
struct Addr { unsigned kb[8]; unsigned vb[2][4]; };
__device__ __forceinline__ void addr_init(Addr& a, int lane) {
    const unsigned r32 = lane & 31, hi = lane >> 5, xr = ((r32 & 3) << 2) | ((r32 >> 2) & 3);
#pragma unroll
    for (int s = 0; s < 8; ++s) a.kb[s] = 256u * r32 + 16u * ((2u * s + hi) ^ xr);
    const unsigned blk = (lane >> 4) & 1, q = (lane & 15) >> 2, p = lane & 3, cl = 2 * blk + (p >> 1), R0 = 4 * hi + q;
#pragma unroll
    for (int t = 0; t < 2; ++t)
#pragma unroll
        for (int c = 0; c < 4; ++c) a.vb[t][c] = 256u * R0 + 64u * ((unsigned)c ^ q) + 16u * (cl ^ (2u * t + hi)) + 8u * (p & 1);
}
template <int SUB> __device__ __forceinline__ f32x16 qk_sub(ldsp Kb, const Addr& a, const bf16x8 (&qr)[8]) {
    f32x16 p = {};
#pragma unroll
    for (int s = 0; s < 8; ++s) { const bf16x8 kf = *(const LAS bf16x8*)(Kb + a.kb[s] + 8192 * SUB); p = __builtin_amdgcn_mfma_f32_32x32x16_bf16(kf, qr[s], p, 0, 0, 0); }
    return p;
}
__device__ __forceinline__ s16x4 vtr(ldsp p) { return __builtin_bit_cast(s16x4, __builtin_amdgcn_ds_read_tr16_b64_v4i16((LAS s16x4*)p)); }
template <int SUB> __device__ __forceinline__ void pv_sub(f32x16 (&o)[4], ldsp Vb, const Addr& a, const f32x16& p) {
    u32x4 w0, w1;
    w0.x = pk2(p[0], p[1]); w0.y = pk2(p[2], p[3]); w0.z = pk2(p[4], p[5]); w0.w = pk2(p[6], p[7]);
    w1.x = pk2(p[8], p[9]); w1.y = pk2(p[10], p[11]); w1.z = pk2(p[12], p[13]); w1.w = pk2(p[14], p[15]);
    const bf16x8 pa0 = __builtin_bit_cast(bf16x8, w0), pa1 = __builtin_bit_cast(bf16x8, w1);
#pragma unroll
    for (int c = 0; c < 4; ++c)
#pragma unroll
        for (int ks = 0; ks < 2; ++ks) {
            const s16x4 lo = vtr(Vb + a.vb[0][c] + 256 * (32 * SUB + 16 * ks)), hi4 = vtr(Vb + a.vb[1][c] + 256 * (32 * SUB + 16 * ks + 8));
            const bf16x8 vf = {lo[0], lo[1], lo[2], lo[3], hi4[0], hi4[1], hi4[2], hi4[3]};
            o[c] = __builtin_amdgcn_mfma_f32_32x32x16_bf16(ks ? pa1 : pa0, vf, o[c], 0, 0, 0);
        }
}
template <bool MASK> __device__ __forceinline__ void sb_sub(f32x16& p, float& carry, int srel, int hi) {
    float L[16];
#pragma unroll
    for (int r = 0; r < 16; ++r) {
        const float z = p[r];
        const float lg = __builtin_amdgcn_logf(1.0f + __builtin_amdgcn_exp2f(-__builtin_fabsf(z)));
        float l = -(__builtin_fmaxf(z, 0.f) + lg);
        if (MASK && (srel + (r & 3) + 8 * (r >> 2) >= 0)) l = 0.f;
        L[r] = l;
    }
    float gs[4], go[4], suf[4];
#pragma unroll
    for (int g = 0; g < 4; ++g) { gs[g] = (L[4 * g] + L[4 * g + 1]) + (L[4 * g + 2] + L[4 * g + 3]); go[g] = __shfl_xor(gs[g], 32); }
    suf[3] = carry; suf[2] = suf[3] + (gs[3] + go[3]); suf[1] = suf[2] + (gs[2] + go[2]); suf[0] = suf[1] + (gs[1] + go[1]); carry = suf[0] + (gs[0] + go[0]);
#pragma unroll
    for (int g = 0; g < 4; ++g) {
        float incl = suf[g] + (hi ? 0.f : go[g]);
#pragma unroll
        for (int e = 3; e >= 0; --e) {
            const int r = 4 * g + e; incl += L[r];
            float w = __builtin_amdgcn_exp2f(p[r] + incl);
            if (MASK && (srel + (r & 3) + 8 * (r >> 2) >= 0)) w = 0.f;
            p[r] = w;
        }
    }
}
__device__ __forceinline__ void store_o(const f32x16 (&o)[4], ldsp stg, bf16* Og  , int lane) {
    asm volatile("" : "+v"(lane));
    const int r32 = lane & 31, hi = lane >> 5;
#pragma unroll
    for (int c = 0; c < 4; ++c)
#pragma unroll
        for (int r = 0; r < 16; ++r) { const int row = (r & 3) + 8 * (r >> 2) + 4 * hi; *(LAS bf16*)(stg + row * 256 + (32 * c + r32) * 2) = (bf16)(pk2(o[c][r], 0.f) & 0xffffu); }
    asm volatile("s_waitcnt lgkmcnt(0)" ::: "memory");
#pragma unroll
    for (int i = 0; i < 8; ++i) { const int row = 4 * i + (lane >> 4), ch = lane & 15; const u32x4 v = *(const LAS u32x4*)(stg + row * 256 + ch * 16); *(u32x4*)(Og + (size_t)row * QP + ch * 8) = v; }
}

__device__ __forceinline__ void sb_unit(int b, int h, int qb, const bf16* Q, const bf16* K, const bf16* V, bf16* O, ldsp lds, const Addr& ad) {
    const int tid = threadIdx.x, lane = tid & 63, r32 = lane & 31, hi = lane >> 5, wid = __builtin_amdgcn_readfirstlane(tid >> 6);
    const int q0 = qb * 256, wmin = q0 + 32 * wid, tq = wmin + r32;
    const size_t rowbase = (size_t)b * SEQ;
    bf16x8 qr[8];
    { const bf16* qp = Q + (rowbase + tq) * QP + h * 128 + hi * 8;
#pragma unroll
      for (int s = 0; s < 8; ++s) qr[s] = *(const bf16x8*)(qp + 16 * s); }
    f32x16 o[4];
#pragma unroll
    for (int c = 0; c < 4; ++c) o[c] = (f32x16){};
    float carry = 0.f;
    const int NT = (q0 + 256) / 64;
    const bf16* Kh = K + rowbase * HW + h * 128; const bf16* Vh = V + rowbase * HW + h * 128;
    unsigned dgo[2];
#pragma unroll
    for (int i = 0; i < 2; ++i) { const unsigned piece = 2 * wid + i, row = 4 * piece + (lane >> 4), xr = (((unsigned)lane >> 4) << 2) | (piece & 3); dgo[i] = row * HW + (((unsigned)lane & 15) ^ xr) * 8; }
#define SB_DMA(kt, buf) do { const bf16* kp_ = Kh + (size_t)(kt) * 64 * HW; const bf16* vp_ = Vh + (size_t)(kt) * 64 * HW; \
        _Pragma("unroll") for (int i_ = 0; i_ < 2; ++i_) { \
            __builtin_amdgcn_global_load_lds((const unsigned*)(kp_ + dgo[i_]), (LAS unsigned*)(lds + KB0 + (buf) * TILEB + (2 * wid + i_) * 1024), 16, 0, 0); \
            __builtin_amdgcn_global_load_lds((const unsigned*)(vp_ + dgo[i_]), (LAS unsigned*)(lds + VB0 + (buf) * TILEB + (2 * wid + i_) * 1024), 16, 0, 0); } } while (0)
    LAS int* doneAt = (LAS int*)(lds + DONE);
    if (tid < 8) doneAt[tid] = 0x7fffffff;
    bool wdone = false;
    SB_DMA(NT - 1, 0); __syncthreads();
    for (int it = 0; it < NT; ++it) {
        const int kt = NT - 1 - it, cur = it & 1;
        if (it + 1 < NT) SB_DMA(kt - 1, cur ^ 1);
        const int k0 = 64 * kt;
        if (!wdone && k0 < wmin + 31) {
            ldsp Kb = lds + KB0 + cur * TILEB, Vb = lds + VB0 + cur * TILEB;
            if (k0 + 32 < wmin + 31) {
                f32x16 p = qk_sub<1>(Kb, ad, qr);
                const int srel = k0 + 32 + 4 * hi - tq;
                if (k0 + 63 >= wmin) sb_sub<true>(p, carry, srel, hi); else sb_sub<false>(p, carry, srel, hi);
                pv_sub<1>(o, Vb, ad, p);
            }
            {
                f32x16 p = qk_sub<0>(Kb, ad, qr);
                const int srel = k0 + 4 * hi - tq;
                if (k0 + 31 >= wmin) sb_sub<true>(p, carry, srel, hi); else sb_sub<false>(p, carry, srel, hi);
                pv_sub<0>(o, Vb, ad, p);
            }
            if (__all(carry < -150.0f)) { wdone = true; if (lane == 0) doneAt[wid] = it; }
        }
        __syncthreads();
        { const LAS u32x4* dp = (const LAS u32x4*)doneAt; const u32x4 d0 = dp[0], d1 = dp[1];
          int mxd = (int)d0.x; mxd = max(mxd, (int)d0.y); mxd = max(mxd, (int)d0.z); mxd = max(mxd, (int)d0.w); mxd = max(mxd, (int)d1.x); mxd = max(mxd, (int)d1.y); mxd = max(mxd, (int)d1.z); mxd = max(mxd, (int)d1.w);
          if (__builtin_amdgcn_readfirstlane(mxd) <= it) break; }
    }
#undef SB_DMA
    store_o(o, lds + wid * 8192, O + (rowbase + wmin) * QP + h * 128, lane);
    __syncthreads();
}

__device__ __forceinline__ void ca_unit(int b, int h, int cb, const bf16* Q, const bf16* K, const bf16* V, bf16* O, const float* qkss,
                                        const float* gq, const float* gk, const float* relbias, ldsp lds, const Addr& ad) {
    const int tid = threadIdx.x, lane = tid & 63, r32 = lane & 31, hi = lane >> 5, wid = __builtin_amdgcn_readfirstlane(tid >> 6);
    const int c0 = cb * 4, cw = c0 + (wid >> 1), irow = 32 * (wid & 1) + r32, tq = 64 * cw + irow;
    const size_t rowbase = (size_t)b * SEQ;
    LAS float* relb = (LAS float*)(lds + RELB); LAS float* gqk = (LAS float*)(lds + GQK); LAS float* ksc = (LAS float*)(lds + KSC);
    LAS float* wsf = (LAS float*)(lds + WSC) + wid * 64;
    { int t2 = tid; asm volatile("" : "+v"(t2));
      if (t2 < 192) relb[t2] = relbias[h * 192 + t2] * LOG2E;
      if (t2 >= 256 && t2 < 384) { const int d = t2 - 256; gqk[d] = gq[d] * gk[d] * C2; } }
    __syncthreads();
    bf16x8 qr[8];
    { const f32x4 pq = *(const f32x4*)(qkss + (rowbase + tq) * 64 + h * 4);
      const float rq = rsqrtf(((pq[0] + pq[1]) + (pq[2] + pq[3])) * (1.0f / 128.0f) + EPS);
      const bf16* qp = Q + (rowbase + tq) * QP + h * 128 + hi * 8;
#pragma unroll
      for (int s = 0; s < 8; ++s) {
          const u32x4 raw = *(const u32x4*)(qp + 16 * s); const LAS float* g = gqk + 16 * s + 8 * hi;
          u32x4 w; w.x = pk2(bflo(raw.x) * rq * g[0], bfhi(raw.x) * rq * g[1]); w.y = pk2(bflo(raw.y) * rq * g[2], bfhi(raw.y) * rq * g[3]);
          w.z = pk2(bflo(raw.z) * rq * g[4], bfhi(raw.z) * rq * g[5]); w.w = pk2(bflo(raw.w) * rq * g[6], bfhi(raw.w) * rq * g[7]);
          qr[s] = __builtin_bit_cast(bf16x8, w);
      } }
    f32x16 o[4];
#pragma unroll
    for (int c = 0; c < 4; ++c) o[c] = (f32x16){};
    float mrun = -1e30f, lrun = 0.f;
    const int kc0 = (c0 - 8 > 0) ? c0 - 8 : 0, NT = c0 + 4 - kc0;
    const bf16* Kh = K + rowbase * HW + h * 128; const bf16* Vh = V + rowbase * HW + h * 128;
    unsigned dgo[2];
#pragma unroll
    for (int i = 0; i < 2; ++i) { const unsigned piece = 2 * wid + i, row = 4 * piece + (lane >> 4), xr = (((unsigned)lane >> 4) << 2) | (piece & 3); dgo[i] = row * HW + (((unsigned)lane & 15) ^ xr) * 8; }
    f32x4 kpr = {1.f, 1.f, 1.f, 1.f};
#define CA_DMA(kc, buf) do { const bf16* kp_ = Kh + (size_t)(kc) * 64 * HW; const bf16* vp_ = Vh + (size_t)(kc) * 64 * HW; \
        _Pragma("unroll") for (int i_ = 0; i_ < 2; ++i_) { \
            __builtin_amdgcn_global_load_lds((const unsigned*)(kp_ + dgo[i_]), (LAS unsigned*)(lds + KB0 + (buf) * TILEB + (2 * wid + i_) * 1024), 16, 0, 0); \
            __builtin_amdgcn_global_load_lds((const unsigned*)(vp_ + dgo[i_]), (LAS unsigned*)(lds + VB0 + (buf) * TILEB + (2 * wid + i_) * 1024), 16, 0, 0); } \
        if (tid < 64) kpr = *(const f32x4*)(qkss + (rowbase + (size_t)(kc) * 64 + tid) * 64 + (8 + h) * 4); } while (0)
#define CA_KSC(buf) do { if (tid < 64) ksc[(buf) * 64 + tid] = rsqrtf(((kpr[0] + kpr[1]) + (kpr[2] + kpr[3])) * (1.0f / 128.0f) + EPS); } while (0)
    CA_DMA(kc0, 0); CA_KSC(0); __syncthreads();
    for (int it = 0; it < NT; ++it) {
        const int kc = kc0 + it, cur = it & 1;
        if (it + 1 < NT) CA_DMA(kc + 1, cur ^ 1);
        const int jc = kc - (cw - 8);
        if (jc >= 0 && jc <= 8) {
            ldsp Kb = lds + KB0 + cur * TILEB, Vb = lds + VB0 + cur * TILEB;
            const LAS float* kscb = ksc + cur * 64 + 4 * hi;
            const int dbase = irow + 64 * (8 - jc) - 4 * hi;
#define CA_SUB(SUB) do { \
            f32x16 p = qk_sub<SUB>(Kb, ad, qr); \
            if (jc <= 5) { const float bc = relb[191]; \
                _Pragma("unroll") for (int g = 0; g < 4; ++g) { const f32x4 s0 = *(const LAS f32x4*)(kscb + 32 * SUB + 8 * g); \
                    _Pragma("unroll") for (int e = 0; e < 4; ++e) p[4 * g + e] = p[4 * g + e] * s0[e] + bc; } \
            } else { \
                _Pragma("unroll") for (int g = 0; g < 4; ++g) { const f32x4 s0 = *(const LAS f32x4*)(kscb + 32 * SUB + 8 * g); \
                    _Pragma("unroll") for (int e = 0; e < 4; ++e) { const int d0 = dbase - (32 * SUB + 8 * g + e); p[4 * g + e] = p[4 * g + e] * s0[e] + relb[(d0 < 128 ? d0 : 128) + 63]; } } \
            } \
            float mx = p[0]; \
            _Pragma("unroll") for (int r = 1; r < 16; ++r) mx = __builtin_fmaxf(mx, p[r]); \
            mx = __builtin_fmaxf(mx, __shfl_xor(mx, 32)); \
            const float mnew = __builtin_fmaxf(mrun, mx); \
            if (__any(mnew > mrun)) { \
                const float alpha = __builtin_amdgcn_exp2f(mrun - mnew); lrun *= alpha; mrun = mnew; \
                if (hi == 0) wsf[r32] = alpha; \
                asm volatile("s_waitcnt lgkmcnt(0)" ::: "memory"); \
                _Pragma("unroll") for (int g = 0; g < 4; ++g) { const f32x4 al = *(const LAS f32x4*)(wsf + 8 * g + 4 * hi); \
                    _Pragma("unroll") for (int c = 0; c < 4; ++c) _Pragma("unroll") for (int e = 0; e < 4; ++e) o[c][4 * g + e] *= al[e]; } \
            } \
            float ps = 0.f; \
            _Pragma("unroll") for (int r = 0; r < 16; ++r) { p[r] = __builtin_amdgcn_exp2f(p[r] - mrun); ps += p[r]; } \
            lrun += ps; \
            pv_sub<SUB>(o, Vb, ad, p); } while (0)
            CA_SUB(0); CA_SUB(1);
#undef CA_SUB
        }
        if (it + 1 < NT) CA_KSC(cur ^ 1);
        __syncthreads();
    }
#undef CA_DMA
#undef CA_KSC
    { const float lt = lrun + __shfl_xor(lrun, 32);
      if (hi == 0) wsf[r32] = __builtin_amdgcn_rcpf(lt);
      asm volatile("s_waitcnt lgkmcnt(0)" ::: "memory");
#pragma unroll
      for (int g = 0; g < 4; ++g) { const f32x4 al = *(const LAS f32x4*)(wsf + 8 * g + 4 * hi);
#pragma unroll
          for (int c = 0; c < 4; ++c)
#pragma unroll
              for (int e = 0; e < 4; ++e) o[c][4 * g + e] *= al[e]; } }
    store_o(o, lds + wid * 8192, O + (rowbase + 64 * cw + 32 * (wid & 1)) * QP + h * 128, lane);
    __syncthreads();
}
}

#define RLX_AGENT __ATOMIC_RELAXED, __HIP_MEMORY_SCOPE_AGENT
#define XB_TMO      128
#define XB_XCNT(j)  (256  + 64 * (j))
#define XB_XSUB(j)  (1280 + 64 * (j))
#define XB_XGEN(j)  (2304 + 64 * (j))
#define XB_TOP      3328
#define XB_TOPGEN   3392
#define XCD_BAR_WORDS 3456
#define XB_SPIN_CAP (1u << 18)

__device__ __forceinline__ unsigned xb_ld(unsigned* p)              { return __hip_atomic_load(p, __ATOMIC_RELAXED, __HIP_MEMORY_SCOPE_AGENT); }
__device__ __forceinline__ unsigned xb_add(unsigned* p, unsigned v) { return __hip_atomic_fetch_add(p, v, __ATOMIC_RELAXED, __HIP_MEMORY_SCOPE_AGENT); }
__device__ __forceinline__ unsigned xb_xcc_id() { return (unsigned)__builtin_amdgcn_s_getreg((3 << 11) | 20) & 0xFu; }
#define XB_SPIN(cond, bar) do { unsigned _sp = 0; while (cond) { __builtin_amdgcn_s_sleep(1); \
    if ((++_sp & 255u) == 0u) { if (xb_ld(&(bar)[XB_TMO])) break; if (_sp > XB_SPIN_CAP) { atomicAdd(&(bar)[XB_TMO], 1u); break; } } } } while (0)

struct XcdBarrier {
    unsigned* bar; unsigned x;
    volatile LAS unsigned* st;
};

__device__ __forceinline__ XcdBarrier xcd_barrier_post(unsigned* bar, volatile LAS unsigned* st) {
    XcdBarrier b; b.bar = bar; b.x = xb_xcc_id(); b.st = st;
    if (threadIdx.x == 0) (void)xb_add(&bar[XB_XCNT(b.x)], 1u);
    return b;
}
__device__ __forceinline__ void xcd_barrier_complete(unsigned* bar, unsigned x, unsigned& nloc, unsigned& nx) {
    const unsigned G = gridDim.x * gridDim.y * gridDim.z;
    unsigned sum, cnt, mine, sp = 0u;
    for (;;) {
        sum = 0u; cnt = 0u; mine = 0u;
#pragma unroll
        for (unsigned j = 0; j < 16; ++j) { const unsigned c = xb_ld(&bar[XB_XCNT(j)]); sum += c; cnt += (c > 0u) ? 1u : 0u; mine = (j == x) ? c : mine; }
        if (sum == G) break;
        __builtin_amdgcn_s_sleep(1);
        if ((++sp & 255u) == 0u) { if (xb_ld(&bar[XB_TMO])) break; if (sp > XB_SPIN_CAP) { atomicAdd(&bar[XB_TMO], 1u); break; } }
    }
    nloc = mine > 0u ? mine : 1u; nx = cnt > 0u ? cnt : 1u;
}

__device__ __forceinline__ void xcd_barrier(const XcdBarrier& b) {
    asm volatile("s_waitcnt vmcnt(0)" ::: "memory");
    __syncthreads();
    if (threadIdx.x == 0) {
        unsigned* bar = b.bar;
        __builtin_amdgcn_s_waitcnt(0);
        unsigned nloc = b.st[0], nx = b.st[1];
        if (nloc == 0u) { xcd_barrier_complete(bar, b.x, nloc, nx); b.st[0] = nloc; b.st[1] = nx; }
        const unsigned old = xb_add(&bar[XB_XSUB(b.x)], 1u);
        const unsigned gen = old / nloc;
        if (old + 1u == (gen + 1u) * nloc) {
            __builtin_amdgcn_fence(__ATOMIC_RELEASE, "agent");
            asm volatile("s_waitcnt vmcnt(0)" ::: "memory");
            const unsigned og = xb_add(&bar[XB_TOP], 1u);
            const unsigned tg = og / nx;
            if (og + 1u == (tg + 1u) * nx) xb_add(&bar[XB_TOPGEN], 1u);
            else XB_SPIN(xb_ld(&bar[XB_TOPGEN]) == tg, bar);
            __builtin_amdgcn_fence(__ATOMIC_ACQUIRE, "agent");
            xb_add(&bar[XB_XGEN(b.x)], 1u);
            asm volatile("s_waitcnt vmcnt(0)" ::: "memory");
        } else {
            XB_SPIN(xb_ld(&bar[XB_XGEN(b.x)]) == gen, bar);
            __builtin_amdgcn_fence(__ATOMIC_ACQUIRE, "agent");
            asm volatile("s_waitcnt vmcnt(0)" ::: "memory");
        }
    }
    __syncthreads();
}

constexpr int NWAVES = 8, NTHREADS = 512;
constexpr int LDS_BYTES = 147456;
constexpr size_t MiB = 1u << 20;
constexpr size_t WS_SSA = 1 * MiB, WS_SSB = 3 * MiB, WS_QKSS = 5 * MiB;
constexpr size_t WS_WIN = 10 * MiB, WS_WOA = 50 * MiB, WS_WOB = 54 * MiB, WS_WOUT = 58 * MiB;
constexpr size_t WS_W2GU = 66 * MiB, WS_W2D = 110 * MiB, WS_XB = 66 * MiB;
constexpr size_t WS_W1GU = 132 * MiB, WS_W1D = 176 * MiB, WS_QSB = 132 * MiB, WS_QCA = 164 * MiB, WS_X2B = 132 * MiB;
constexpr size_t WS_H = 198 * MiB, WS_KSB = 198 * MiB, WS_VSB = 230 * MiB, WS_KCA = 262 * MiB, WS_VCA = 294 * MiB, WS_G = 198 * MiB, WS_GATES = 326 * MiB;
constexpr size_t WS_END = 454 * MiB;
constexpr int NPH = 9;

__device__ __forceinline__ float wave_sum(float v) {
#pragma unroll
    for (int o = 1; o < 64; o <<= 1) v += __shfl_xor(v, o);
    return v;
}
__device__ __forceinline__ void tr_item(const float* W, int N, int K, bf16* WT, int k0, int n0, int drow0, const float* gain, LAS float* scr, int lane, int blk_nt = 0) {
    const int ko = lane >> 3, nq = lane & 7;
    const float* src = W + (size_t)(k0 + 8 * ko) * N + n0 + 4 * nq;
    f32x4 v[8];
#pragma unroll
    for (int j = 0; j < 8; ++j) v[j] = __builtin_nontemporal_load((const f32x4*)(src + (size_t)j * N));
    if (gain) { const f32x4 g0 = *(const f32x4*)(gain + k0 + 8 * ko), g1 = *(const f32x4*)(gain + k0 + 8 * ko + 4);
#pragma unroll
        for (int j = 0; j < 4; ++j) { v[j] = v[j] * g0[j]; v[4 + j] = v[4 + j] * g1[j]; } }
    const int nrow = drow0 + 4 * nq;
    bf16* dst = blk_nt ? WT + ((size_t)(nrow >> 8) * blk_nt + (k0 >> 6)) * 16384 + (size_t)(nrow & 255) * 64 + 8 * ko : WT + (size_t)nrow * K + k0 + 8 * ko;
    const size_t rstride = blk_nt ? 64 : (size_t)K;
#pragma unroll
    for (int i = 0; i < 4; ++i) { u32x4 o; o.x = pk2(v[0][i], v[1][i]); o.y = pk2(v[2][i], v[3][i]); o.z = pk2(v[4][i], v[5][i]); o.w = pk2(v[6][i], v[7][i]);
        *(u32x4*)(dst + (size_t)i * rstride) = o; }
}
__device__ __forceinline__ void tr_plain(const float* W, int K, int N, bf16* WT, const float* gain, LAS float* scr, int item, int lane, int pitch = 0, bool blk = false) {
    const int nblk = N / 32, kb = item / nblk, nb = item % nblk; tr_item(W, N, pitch ? pitch : K, WT, 64 * kb, 32 * nb, 32 * nb, gain, scr, lane, blk ? K / 64 : 0);
}
__device__ __forceinline__ void tr_gu(const float* Wg, const float* Wu, bf16* WT, const float* gain, LAS float* scr, int item, int lane) {
    constexpr int nblk = DFF / 32, per = (DM / 64) * nblk; const int mat = item / per, r = item % per, kb = r / nblk, n0 = 32 * (r % nblk);
    tr_item(mat ? Wu : Wg, DFF, DM, WT, 64 * kb, n0, 256 * (n0 >> 7) + 128 * mat + (n0 & 127), gain, scr, lane);
}

struct Args { const float* in[19]; float* out; unsigned char* ws; int ph_lo, ph_hi; };
static_assert(sizeof(Args) == 19 * 8 + 8 + 8 + 8, "Args has no padding");

__global__ void __launch_bounds__(NTHREADS, 2) fwd(Args args) {
    extern __shared__ __attribute__((aligned(16))) unsigned char lds_raw[];
    ldsp lds = (ldsp)lds_raw;
    const int tid = threadIdx.x, lane = tid & 63, wave = __builtin_amdgcn_readfirstlane(tid >> 6);
    const int G = gridDim.x, bx = blockIdx.x, vcu = (G % 8 == 0) ? (bx % 8) * (G / 8) + bx / 8 : bx;
    unsigned char* ws = args.ws;
    const float* x = args.in[0]; float* X = args.out;
#define ssA ((float*)(ws + WS_SSA))
#define ssB ((float*)(ws + WS_SSB))
#define qkss ((float*)(ws + WS_QKSS))
#define Win ((bf16*)(ws + WS_WIN))
#define WoA ((bf16*)(ws + WS_WOA))
#define WoB ((bf16*)(ws + WS_WOB))
#define Wout ((bf16*)(ws + WS_WOUT))
#define W2gu ((bf16*)(ws + WS_W2GU))
#define W2d ((bf16*)(ws + WS_W2D))
#define XB ((bf16*)(ws + WS_XB))
#define W1gu ((bf16*)(ws + WS_W1GU))
#define W1d ((bf16*)(ws + WS_W1D))
#define QSB ((bf16*)(ws + WS_QSB))
#define QCA (QSB + HW)
#define X2B ((bf16*)(ws + WS_X2B))
#define Hb ((bf16*)(ws + WS_H))
#define KSB ((bf16*)(ws + WS_KSB))
#define VSB ((bf16*)(ws + WS_VSB))
#define KCA ((bf16*)(ws + WS_KCA))
#define VCA ((bf16*)(ws + WS_VCA))
#define Gm ((bf16*)(ws + WS_G))
#define GATES ((bf16*)(ws + WS_GATES))
    const int lo = args.ph_lo, hi = args.ph_hi;
    cg::grid_group grid = cg::this_grid();
    volatile LAS unsigned* MISC = (volatile LAS unsigned*)(lds + 131072);
    if (tid < 64) MISC[tid] = 0u;
    __syncthreads();
    XcdBarrier xbar; xbar.bar = (unsigned*)ws; xbar.x = 0; xbar.st = MISC + 8;
    if (hi - lo > 1) xbar = xcd_barrier_post((unsigned*)ws, MISC + 8);
    if (lo < 0) grid.sync();
#ifndef PH_MASK
#define PH_MASK 0x3ff
#endif
#define IN(k) (((PH_MASK >> (k)) & 1) && lo <= (k) && (k) < hi)
#define SEAM(k) do { if (IN(k) && IN((k) + 1)) xcd_barrier(xbar); } while (0)
    const int gw = vcu * NWAVES + wave, NGW = G * NWAVES;
    LAS float* scr = (LAS float*)(lds + wave * 16384);

    if (IN(0)) {
        constexpr int I_GU = 2 * (DM / 64) * (DFF / 32), I_D = (DFF / 64) * (DM / 32), I_IN = (DM / 64) * (NIN / 32), I_O = (HW / 64) * (DM / 32), I_OUT = (DM / 64) * (DM / 32);
        constexpr int NITEMS = I_GU + I_D + I_IN + 2 * I_O + I_OUT;
        for (int it = gw; it < NITEMS; it += NGW) {
            int r = it;
            if (r < I_GU) { tr_gu(args.in[2], args.in[3], W1gu, args.in[1], scr, r, lane); continue; } r -= I_GU;
            if (r < I_D) { tr_plain(args.in[4], DFF, DM, W1d, nullptr, scr, r, lane, 0, true); continue; } r -= I_D;
            if (r < I_IN) { tr_plain(args.in[6], DM, NIN, Win, args.in[5], scr, r, lane); continue; } r -= I_IN;
            if (r < I_O) { tr_plain(args.in[11], HW, DM, WoA, nullptr, scr, r, lane, 2 * HW); continue; } r -= I_O;
            if (r < I_O) { tr_plain(args.in[12], HW, DM, WoA + HW, nullptr, scr, r, lane, 2 * HW); continue; } r -= I_O;
            tr_plain(args.in[13], DM, DM, Wout, nullptr, scr, r, lane);
        }
        for (int m = gw; m < M; m += NGW) {
            const f32x4* xr = (const f32x4*)(x + (size_t)m * DM) + lane; f32x4 v[8]; float s = 0.f;
#pragma unroll
            for (int j = 0; j < 8; ++j) { v[j] = xr[64 * j]; s += (v[j][0] * v[j][0] + v[j][1] * v[j][1]) + (v[j][2] * v[j][2] + v[j][3] * v[j][3]); }
            s = wave_sum(s);
            u32x2* o8 = (u32x2*)(XB + (size_t)m * DM) + lane;
#pragma unroll
            for (int j = 0; j < 8; ++j) { u32x2 w; w.x = pk2(v[j][0], v[j][1]); w.y = pk2(v[j][2], v[j][3]); o8[64 * j] = w; }
            if (lane < NSS) ssA[(size_t)m * NSS + lane] = (lane == 0) ? s : 0.f;
        }
    }
    SEAM(0);
    if (IN(1)) {
        pg8::Gemm g{XB, W1gu, M, 2 * DFF, DM}; pg8::StaticOrder S; S.init(M, 2 * DFF, G, bx);
        pg8::EpiSwiglu E{Hb, ssA};
        pg8::gemm_phase<pg8::EpiSwiglu, pg8::StaticOrder, true, true>(lds, g, S, E);
    }
    SEAM(1);
    if (IN(2)) {
        pg8::Gemm g{Hb, W1d, M, DM, DFF, true, true}; pg8::StaticOrder S; S.init(M, DM, G, bx);
        pg8::EpiResid<false> E{x, nullptr, (bf16*)X, ssB, 0.5f};
        pg8::gemm_phase<pg8::EpiResid<false>, pg8::StaticOrder, true, true>(lds, g, S, E);
    }
    SEAM(2);
    if (IN(3)) {
        pg8::Gemm g{(const bf16*)X, Win, M, NIN, DM}; pg8::StaticOrder S; S.init(M, NIN, G, bx);
        int pmA = -1, pmB = -1;
        { pg8::Unit uu; for (int i = 0; S.next(i, uu); ++i) { if (pmA < 0) pmA = uu.pm; else if (uu.pm != pmA) pmB = uu.pm; } }
        LAS float* rtab = (LAS float*)(lds + 132096);
        { const int trow = tid & 255, tpm = (tid < 256) ? pmA : pmB;
          if (tpm >= 0) { const f32x4* p = (const f32x4*)(ssB + (size_t)(tpm * 256 + trow) * NSS); float sacc = 0.f;
#pragma unroll
              for (int j = 0; j < 8; ++j) { const f32x4 v = p[j]; sacc += (v[0] + v[1]) + (v[2] + v[3]); }
              rtab[tid] = rsqrtf(sacc * (1.0f / DM) + EPS); } }
        __syncthreads();
        pg8::EpiIn E{QSB, KSB, VSB, QCA, KCA, VCA, GATES, qkss, ssB, args.in[7], rtab, pmA};
        pg8::gemm_phase<pg8::EpiIn, pg8::StaticOrder, true, true>(lds, g, S, E);
    }
    SEAM(3);
    if (IN(4)) {
        att::Addr ad; att::addr_init(ad, lane);
        constexpr int I_GU = 2 * (DM / 64) * (DFF / 32), I_D = (DFF / 64) * (DM / 32);
        const int cslot = vcu % 3;
#define W2_COPIES() do { for (int it = gw; it < I_GU + I_D; it += NGW) { \
            if (it < I_GU) tr_gu(args.in[15], args.in[16], W2gu, args.in[14], scr, it, lane); \
            else tr_plain(args.in[17], DFF, DM, W2d, nullptr, scr, it - I_GU, lane, 0, true); } } while (0)
        if (cslot == 0) W2_COPIES();
        for (int u = vcu; u < 256; u += G) {
            const int bh = u >> 3, s = u & 7;
            att::sb_unit(bh >> 3, bh & 7, s, QSB, KSB, VSB, QSB, lds, ad);
            att::sb_unit(bh >> 3, bh & 7, 15 - s, QSB, KSB, VSB, QSB, lds, ad);
        }
        if (cslot == 1) W2_COPIES();
        for (int u = vcu; u < 512; u += G) {
            const int bh = u >> 4;
            att::ca_unit(bh >> 3, bh & 7, u & 15, QCA, KCA, VCA, QCA, qkss, args.in[8], args.in[9], args.in[10], lds, ad);
        }
        if (cslot == 2) W2_COPIES();
#undef W2_COPIES
    }
    SEAM(4);
    if (IN(5)) {
        pg8::Gemm g{QSB, WoA, M, DM, 2 * HW}; pg8::StaticOrder S; S.init(M, DM, G, bx); pg8::EpiGateF E{GATES, Gm};
        pg8::gemm_phase<pg8::EpiGateF, pg8::StaticOrder, true, true>(lds, g, S, E);
    }
    SEAM(5);
    if (IN(6)) {
        pg8::Gemm g{Gm, Wout, M, DM, DM}; pg8::StaticOrder S; S.init(M, DM, G, bx);
        pg8::EpiResid<true> E{(const bf16*)X, nullptr, X2B, ssA, 1.0f};
        pg8::gemm_phase<pg8::EpiResid<true>, pg8::StaticOrder, true, true>(lds, g, S, E);
    }
    SEAM(6);
    if (IN(7)) {
        pg8::Gemm g{X2B, W2gu, M, 2 * DFF, DM}; pg8::StaticOrder S; S.init(M, 2 * DFF, G, bx);
        pg8::EpiSwiglu E{Hb, ssA};
        pg8::gemm_phase<pg8::EpiSwiglu, pg8::StaticOrder, true, true>(lds, g, S, E);
    }
    SEAM(7);
    if (IN(8)) {
        pg8::Gemm g{Hb, W2d, M, DM, DFF, true, true};
        pg8::PanelOrder S; S.init(bx);
        pg8::EpiFinal E{X2B, X, args.in[18], (float*)(ws + 512 * 1024), (unsigned*)(ws + 32 * 1024), lds + 132096, 0.5f};
        pg8::gemm_phase<pg8::EpiFinal, pg8::PanelOrder, true, true>(lds, g, S, E);
    }
#undef IN
#undef SEAM
}

extern "C" void kernel_launch(void* const* d_in, const int* in_sizes, int n_in, void* d_out, int out_size, void* d_ws, size_t ws_size, hipStream_t stream) {
    static int grid = 0;
    if (grid == 0) {
        if (n_in != 19 || in_sizes[0] != M * DM || out_size != M * DM || ws_size < WS_END) { fprintf(stderr, "kernel_launch: unexpected shapes / workspace (n_in %d, ws %zu)\n", n_in, ws_size); grid = -1; return; }
        int dev = 0, cus = 0, per_cu = 0;
        if (hipGetDevice(&dev) != hipSuccess || hipDeviceGetAttribute(&cus, hipDeviceAttributeMultiprocessorCount, dev) != hipSuccess) { grid = -1; return; }
        if (hipFuncSetAttribute((const void*)fwd, hipFuncAttributeMaxDynamicSharedMemorySize, LDS_BYTES) != hipSuccess) { fprintf(stderr, "kernel_launch: hipFuncSetAttribute failed\n"); grid = -1; return; }
        if (hipOccupancyMaxActiveBlocksPerMultiprocessor(&per_cu, (const void*)fwd, NTHREADS, LDS_BYTES) != hipSuccess || per_cu < 1) { fprintf(stderr, "kernel_launch: occupancy query gave %d\n", per_cu); per_cu = 1; }
        (void)hipGetLastError();
        grid = cus * per_cu;
        if (grid != 256) { fprintf(stderr, "kernel_launch: this kernel needs exactly 256 resident workgroups (one per CU of a 256-CU MI355X); got %d; nothing launched\n", grid); grid = -1; return; }
    }
    if (grid < 0) return;
    if (hipMemsetAsync(d_ws, 0, 65536, stream) != hipSuccess) { fprintf(stderr, "kernel_launch: memset failed\n"); return; }
    Args a{};
    for (int i = 0; i < 19; ++i) a.in[i] = (const float*)d_in[i];
    a.out = (float*)d_out; a.ws = (unsigned char*)d_ws;
#if MK_MULTI
    for (int p = 0; p < NPH; ++p) { a.ph_lo = p; a.ph_hi = p + 1; hipLaunchKernelGGL(fwd, dim3(grid), dim3(NTHREADS), LDS_BYTES, stream, a); }
#else
    a.ph_lo = 0; a.ph_hi = NPH;
    void* kargs[] = {&a};
    hipError_t e = hipLaunchCooperativeKernel((const void*)fwd, dim3(grid), dim3(NTHREADS), kargs, LDS_BYTES, stream);
    if (e != hipSuccess) fprintf(stderr, "kernel_launch: cooperative launch failed: %s (grid %d)\n", hipGetErrorString(e), grid);
#ifdef PROBE_EXTRA
    { static const int kExtra[] = {PROBE_EXTRA}; Args p = a; p.out = (float*)((unsigned char*)d_ws + WS_GATES);
      for (unsigned i = 0; i < sizeof(kExtra) / sizeof(kExtra[0]); ++i) { p.ph_lo = kExtra[i]; p.ph_hi = kExtra[i] + 1; hipLaunchKernelGGL(fwd, dim3(grid), dim3(NTHREADS), LDS_BYTES, stream, p); } }
#endif
#endif
}
```
